# Optimizing an MI355X kernel written in HIP

```python
import math
import jax, jax.numpy as jnp
from jax import lax
import numpy as np

D_MODEL = 2048
BATCH = 4
SEQ = 2048
DEPTH = 1

MIX_WIDTH = D_MODEL
GLA_WIDTH = MIX_WIDTH // 2
NSA_WIDTH = MIX_WIDTH - GLA_WIDTH
GLA_HEADS = 4
GLA_DK = (GLA_WIDTH // 2) // GLA_HEADS
GLA_DV = GLA_WIDTH // GLA_HEADS
GLA_GATE_RANK = 16
GLA_GATE_NORM = 16.0
GLA_CHUNK = 64
NSA_HEADS = 8
NSA_HD = NSA_WIDTH // NSA_HEADS
NSA_KV_GROUPS = 2
NSA_HPG = NSA_HEADS // NSA_KV_GROUPS
CMP_BLOCK = 32
CMP_STRIDE = 16
CMP_HIDDEN = 2 * NSA_HD
SLC_BLOCK = 64
SLC_TOPK = 16
SLC_QCHUNK = 64
WINDOW = 512
WIN_QBLOCK = 128
ROPE_THETA = 500000.0
ROPE_DIM = NSA_HD // 4
FFN_HIDDEN = -(-8 * D_MODEL // (3 * 256)) * 256
DEEPNORM_ALPHA = (2.0 * DEPTH) ** 0.25
DEEPNORM_BETA = (8.0 * DEPTH) ** -0.25
LN_EPS = 1e-5
FORCED_SCORE = 1e4
INVALID_SCORE = -1e4

IN_SIZES = (
    GLA_HEADS * GLA_DK,
    GLA_HEADS * GLA_DK,
    GLA_HEADS * GLA_DV,
    GLA_HEADS * GLA_DV,
    GLA_GATE_RANK,
    NSA_HEADS * NSA_HD,
    NSA_KV_GROUPS * NSA_HD,
    NSA_KV_GROUPS * NSA_HD,
    NSA_KV_GROUPS * NSA_HD,
    NSA_KV_GROUPS * NSA_HD,
    NSA_KV_GROUPS * NSA_HD,
    NSA_KV_GROUPS * NSA_HD,
    NSA_HEADS * 3,
)
IN_WIDTH = sum(IN_SIZES)

kernel_name = "hymba_gla_nsa_deepnorm_layer"


def layer_norm(x, g, b):
    xf = x.astype(jnp.float32)
    mu = jnp.mean(xf, axis=-1, keepdims=True)
    var = jnp.mean(jnp.square(xf - mu), axis=-1, keepdims=True)
    y = (xf - mu) * lax.rsqrt(var + LN_EPS) * g.astype(jnp.float32) + b.astype(jnp.float32)
    return y.astype(x.dtype)


def masked_softmax(s, mask):
    s = jnp.where(mask, s.astype(jnp.float32), -jnp.inf)
    m = jnp.max(s, axis=-1, keepdims=True)
    m = jnp.where(jnp.isfinite(m), m, 0.0)
    e = jnp.where(mask, jnp.exp(s - m), 0.0)
    den = jnp.sum(e, axis=-1, keepdims=True)
    return e / jnp.where(den > 0, den, 1.0)


def rope_tables(S):
    pos = jnp.arange(S, dtype=jnp.float32)
    inv = jnp.power(ROPE_THETA, -jnp.arange(0, ROPE_DIM, 2, dtype=jnp.float32) / ROPE_DIM)
    ang = pos[:, None] * inv[None, :]
    return jnp.cos(ang), jnp.sin(ang)


def apply_partial_rope(x, cos, sin):
    half = ROPE_DIM // 2
    c = cos[None, :, None, :].astype(x.dtype)
    s = sin[None, :, None, :].astype(x.dtype)
    x1 = x[..., :half]
    x2 = x[..., half:ROPE_DIM]
    return jnp.concatenate([x1 * c - x2 * s, x2 * c + x1 * s, x[..., ROPE_DIM:]], axis=-1)


def gla_mixer(q, k, v, gk, g_out, norm_w):
    B, S, H, dk = q.shape
    dv = v.shape[-1]
    C = GLA_CHUNK
    nC = S // C

    def chunks(t):
        return t.astype(jnp.float32).reshape(B, nC, C, H, t.shape[-1]).transpose(0, 3, 1, 2, 4)

    qc = chunks(q) * (dk ** -0.5)
    kc = chunks(k)
    vc = chunks(v)
    bc = jnp.cumsum(chunks(gk), axis=3)
    b_last = bc[:, :, :, -1:, :]
    q_dec = qc * jnp.exp(bc)
    k_intra = kc * jnp.exp(-bc)
    k_state = kc * jnp.exp(b_last - bc)
    decay = jnp.exp(b_last[:, :, :, 0, :])

    causal = jnp.tril(jnp.ones((C, C), dtype=bool))
    attn = jnp.where(causal, jnp.einsum('bhnid,bhnjd->bhnij', q_dec, k_intra), 0.0)
    o_intra = jnp.einsum('bhnij,bhnje->bhnie', attn, vc)

    def step(state, inp):
        qd, ks, vv, dec = inp
        o = jnp.einsum('bhid,bhde->bhie', qd, state)
        state = dec[..., None] * state + jnp.einsum('bhjd,bhje->bhde', ks, vv)
        return state, o

    xs = (jnp.moveaxis(q_dec, 2, 0), jnp.moveaxis(k_state, 2, 0),
          jnp.moveaxis(vc, 2, 0), jnp.moveaxis(decay, 2, 0))
    state0 = jnp.zeros((B, H, dk, dv), jnp.float32)
    _, o_inter = lax.scan(step, state0, xs)
    o = o_intra + jnp.moveaxis(o_inter, 0, 2)
    o = o.transpose(0, 2, 3, 1, 4).reshape(B, S, H, dv)
    o = o * lax.rsqrt(jnp.mean(jnp.square(o), axis=-1, keepdims=True) + LN_EPS) * norm_w.astype(jnp.float32)
    o = o.reshape(B, S, H * dv) * jax.nn.silu(g_out.astype(jnp.float32))
    return o.astype(q.dtype)


def compress_blocks(kv, pos_emb, w1, w2):
    B, S, G, hd = kv.shape
    n_cmp = (S - CMP_BLOCK) // CMP_STRIDE + 1
    idx = np.arange(n_cmp)[:, None] * CMP_STRIDE + np.arange(CMP_BLOCK)[None, :]
    blocks = kv[:, idx] + pos_emb[None, None, :, None, :]
    flat = blocks.transpose(0, 1, 3, 2, 4).reshape(B, n_cmp, G, CMP_BLOCK * hd)
    return jax.nn.gelu(flat @ w1) @ w2


def nsa_mixer(q, kc, vc, ks, vs, kw, vw, gate_logits, cmp_k_pos, cmp_k_w1, cmp_k_w2,
              cmp_v_pos, cmp_v_w1, cmp_v_w2, cos, sin):
    B, S, H, hd = q.shape
    G, R = NSA_KV_GROUPS, NSA_HPG
    scale = hd ** -0.5
    t = jnp.arange(S)

    k_cmp = compress_blocks(kc, cmp_k_pos, cmp_k_w1, cmp_k_w2)
    v_cmp = compress_blocks(vc, cmp_v_pos, cmp_v_w1, cmp_v_w2)
    n_cmp = k_cmp.shape[1]
    cmp_end = jnp.arange(n_cmp) * CMP_STRIDE + CMP_BLOCK - 1
    qg = q.reshape(B, S, G, R, hd)
    s_cmp = jnp.einsum('bsgrd,bngd->bsgrn', qg, k_cmp) * scale
    cmp_mask = (cmp_end[None, :] <= t[:, None])[None, :, None, None, :]
    p_cmp = masked_softmax(s_cmp, cmp_mask)
    o_cmp = jnp.einsum('bsgrn,bngd->bsgrd', p_cmp, v_cmp.astype(jnp.float32))

    nb = S // SLC_BLOCK
    k_sel = min(SLC_TOPK, nb)
    c_start = np.arange(n_cmp) * CMP_STRIDE
    b_start = np.arange(nb) * SLC_BLOCK
    overlap = ((c_start[:, None] < b_start[None, :] + SLC_BLOCK) &
               (b_start[None, :] < c_start[:, None] + CMP_BLOCK)).astype(np.float32)
    imp = jnp.einsum('bsgrn,nj->bsgj', p_cmp, jnp.asarray(overlap))
    blk = jnp.arange(nb)
    cur = t // SLC_BLOCK
    valid = blk[None, :] <= cur[:, None]
    forced = (blk[None, :] == 0) | (blk[None, :] == cur[:, None]) | (blk[None, :] == cur[:, None] - 1)
    imp = jnp.where(valid[None, :, None, :], imp, INVALID_SCORE)
    imp = jnp.where(forced[None, :, None, :], FORCED_SCORE, imp)
    _, sel_idx = lax.top_k(imp, k_sel)

    q_r = apply_partial_rope(q, cos, sin).reshape(B, S, G, R, hd)
    k_s = apply_partial_rope(ks, cos, sin)
    k_blocks = k_s.reshape(B, nb, SLC_BLOCK, G, hd).transpose(0, 3, 1, 2, 4)
    v_blocks = vs.reshape(B, nb, SLC_BLOCK, G, hd).transpose(0, 3, 1, 2, 4)
    nQ = S // SLC_QCHUNK
    bi = jnp.arange(B)[:, None, None, None]
    gi = jnp.arange(G)[None, None, :, None]

    def sel_chunk(args):
        qc_, idx, tq = args
        Tq = qc_.shape[1]
        kg = k_blocks[bi, gi, idx]
        vg = v_blocks[bi, gi, idx]
        kpos = idx[..., None] * SLC_BLOCK + jnp.arange(SLC_BLOCK)
        mask = (kpos <= tq[None, :, None, None, None])[:, :, :, None].reshape(B, Tq, G, 1, k_sel * SLC_BLOCK)
        s = jnp.einsum('bqgrd,bqgjcd->bqgrjc', qc_, kg) * scale
        p = masked_softmax(s.reshape(B, Tq, G, R, k_sel * SLC_BLOCK), mask)
        p = p.reshape(B, Tq, G, R, k_sel, SLC_BLOCK)
        return jnp.einsum('bqgrjc,bqgjcd->bqgrd', p, vg.astype(jnp.float32))

    q_chunks = jnp.moveaxis(q_r.reshape(B, nQ, SLC_QCHUNK, G, R, hd), 1, 0)
    i_chunks = jnp.moveaxis(sel_idx.reshape(B, nQ, SLC_QCHUNK, G, k_sel), 1, 0)
    t_chunks = t.reshape(nQ, SLC_QCHUNK)
    o_slc = lax.map(sel_chunk, (q_chunks, i_chunks, t_chunks))
    o_slc = jnp.moveaxis(o_slc, 0, 1).reshape(B, S, G, R, hd)

    k_w = apply_partial_rope(kw, cos, sin)
    nWQ = S // WIN_QBLOCK
    n_pad_blk = WINDOW // WIN_QBLOCK
    nkb = n_pad_blk + 1

    def band(a):
        a = jnp.pad(a, ((0, 0), (WINDOW, 0), (0, 0), (0, 0))).reshape(B, nWQ + n_pad_blk, WIN_QBLOCK, G, hd)
        return jnp.concatenate([a[:, j:j + nWQ] for j in range(nkb)], axis=2)

    kwin = band(k_w)
    vwin = band(vw)
    qw = q_r.reshape(B, nWQ, WIN_QBLOCK, G, R, hd)
    qpos = t.reshape(nWQ, WIN_QBLOCK)
    kpos = jnp.arange(nWQ)[:, None] * WIN_QBLOCK + jnp.arange(nkb * WIN_QBLOCK)[None, :] - WINDOW
    diff = qpos[:, :, None] - kpos[:, None, :]
    win_mask = (kpos[:, None, :] >= 0) & (diff >= 0) & (diff < WINDOW)
    s_win = jnp.einsum('bnqgrd,bnkgd->bnqgrk', qw, kwin) * scale
    p_win = masked_softmax(s_win, win_mask[None, :, :, None, None, :])
    o_win = jnp.einsum('bnqgrk,bnkgd->bnqgrd', p_win, vwin.astype(jnp.float32)).reshape(B, S, G, R, hd)

    g = jax.nn.sigmoid(gate_logits.astype(jnp.float32)).reshape(B, S, G, R, 3)
    o = g[..., 0:1] * o_cmp + g[..., 1:2] * o_slc + g[..., 2:3] * o_win
    return o.reshape(B, S, H * hd).astype(q.dtype)


def setup_inputs(seed: int = 0) -> dict:
    key = jax.random.key(seed)
    ks = jax.random.split(key, 20)
    L = DEPTH

    def nrm(k, shape, scale):
        return jax.random.normal(k, shape, jnp.float32) * scale

    return {
        "x": nrm(ks[0], (BATCH, SEQ, D_MODEL), 1.0),
        "w_in": nrm(ks[1], (L, D_MODEL, IN_WIDTH), D_MODEL ** -0.5),
        "gla_gate_w2": nrm(ks[2], (L, GLA_GATE_RANK, GLA_HEADS * GLA_DK), GLA_GATE_RANK ** -0.5),
        "gla_gate_b2": nrm(ks[3], (L, GLA_HEADS * GLA_DK), 0.1),
        "gla_norm_w": 1.0 + nrm(ks[4], (L, GLA_DV), 0.02),
        "cmp_k_pos": nrm(ks[5], (L, CMP_BLOCK, NSA_HD), 0.1),
        "cmp_k_w1": nrm(ks[6], (L, CMP_BLOCK * NSA_HD, CMP_HIDDEN), (CMP_BLOCK * NSA_HD) ** -0.5),
        "cmp_k_w2": nrm(ks[7], (L, CMP_HIDDEN, NSA_HD), CMP_HIDDEN ** -0.5),
        "cmp_v_pos": nrm(ks[8], (L, CMP_BLOCK, NSA_HD), 0.1),
        "cmp_v_w1": nrm(ks[9], (L, CMP_BLOCK * NSA_HD, CMP_HIDDEN), (CMP_BLOCK * NSA_HD) ** -0.5),
        "cmp_v_w2": nrm(ks[10], (L, CMP_HIDDEN, NSA_HD), CMP_HIDDEN ** -0.5),
        "w_out": nrm(ks[11], (L, MIX_WIDTH, D_MODEL), MIX_WIDTH ** -0.5 * DEEPNORM_BETA),
        "ln1_g": 1.0 + nrm(ks[12], (L, D_MODEL), 0.02),
        "ln1_b": nrm(ks[13], (L, D_MODEL), 0.02),
        "ffn_w1": nrm(ks[14], (L, D_MODEL, FFN_HIDDEN), D_MODEL ** -0.5),
        "ffn_w3": nrm(ks[15], (L, D_MODEL, FFN_HIDDEN), D_MODEL ** -0.5),
        "ffn_w2": nrm(ks[16], (L, FFN_HIDDEN, D_MODEL), FFN_HIDDEN ** -0.5 * DEEPNORM_BETA),
        "ln2_g": 1.0 + nrm(ks[17], (L, D_MODEL), 0.02),
        "ln2_b": nrm(ks[18], (L, D_MODEL), 0.02),
    }


def reference(x, w_in, gla_gate_w2, gla_gate_b2, gla_norm_w, cmp_k_pos, cmp_k_w1, cmp_k_w2,
              cmp_v_pos, cmp_v_w1, cmp_v_w2, w_out, ln1_g, ln1_b, ffn_w1, ffn_w3, ffn_w2,
              ln2_g, ln2_b):
    B, S, _ = x.shape
    cos, sin = rope_tables(S)
    split_points = []
    acc = 0
    for size in IN_SIZES[:-1]:
        acc += size
        split_points.append(acc)

    for l in range(DEPTH):
        u = jnp.einsum('bsd,de->bse', x, w_in[l])
        (g_q, g_k, g_v, g_o, g_lr, n_q, n_kc, n_vc, n_ks, n_vs, n_kw, n_vw, n_gate) = jnp.split(u, split_points, axis=-1)

        gk = jax.nn.log_sigmoid((g_lr @ gla_gate_w2[l] + gla_gate_b2[l]).astype(jnp.float32)) / GLA_GATE_NORM
        o_gla = gla_mixer(g_q.reshape(B, S, GLA_HEADS, GLA_DK), g_k.reshape(B, S, GLA_HEADS, GLA_DK),
                          g_v.reshape(B, S, GLA_HEADS, GLA_DV), gk.reshape(B, S, GLA_HEADS, GLA_DK),
                          g_o, gla_norm_w[l])

        kvs = lambda a: a.reshape(B, S, NSA_KV_GROUPS, NSA_HD)
        o_nsa = nsa_mixer(n_q.reshape(B, S, NSA_HEADS, NSA_HD), kvs(n_kc), kvs(n_vc), kvs(n_ks), kvs(n_vs),
                          kvs(n_kw), kvs(n_vw), n_gate.reshape(B, S, NSA_HEADS, 3),
                          cmp_k_pos[l], cmp_k_w1[l], cmp_k_w2[l], cmp_v_pos[l], cmp_v_w1[l], cmp_v_w2[l],
                          cos, sin)

        mix = jnp.einsum('bse,ed->bsd', jnp.concatenate([o_gla, o_nsa], axis=-1), w_out[l])
        h = layer_norm(DEEPNORM_ALPHA * x + mix, ln1_g[l], ln1_b[l])
        ffn = (jax.nn.silu(h @ ffn_w1[l]) * (h @ ffn_w3[l])) @ ffn_w2[l]
        x = layer_norm(DEEPNORM_ALPHA * h + ffn, ln2_g[l], ln2_b[l])
    return x
```

```cpp
#include <hip/hip_runtime.h>
#include <hip/hip_cooperative_groups.h>
#include <cstdio>
#include <cstdint>
namespace cg = cooperative_groups;
#define MK_ONE 1
namespace pg8 {
#define PG8_LAS __attribute__((address_space(3)))
typedef unsigned short bf16_t;
typedef short bf16x8 __attribute__((ext_vector_type(8)));
typedef float f32x4 __attribute__((ext_vector_type(4)));
typedef unsigned u32x4 __attribute__((ext_vector_type(4)));
constexpr int BM = 256, BK = 64, HALF = 128, HTB = HALF * BK * 2  , STAGE_BYTES = 8 * HTB, NXCD = 8, WGM = 8;

__host__ __device__ __forceinline__ int lds_byte(int r, int c) { const int st = (r >> 4) * 2 + (c >> 5), rr = r & 15, cc = c & 31, ob = rr * 64 + cc * 2; return st * 1024 + (ob ^ (((ob >> 9) & 1) << 5)); }
__host__ __device__ __forceinline__ void stage_rc(int b, int& R, int& C) { const int st = b / 1024, sb = b % 1024, swz = sb ^ (((sb >> 9) & 1) << 5); R = (st >> 1) * 16 + swz / 64; C = (st & 1) * 32 + (swz % 64) / 2; }
__host__ __device__ __forceinline__ int perm32(int rho) { const int n = rho >> 4, i = rho & 15; return 8 * (i >> 2) + 4 * n + (i & 3); }

struct Unit { int pm, pn; };
struct Gemm { const bf16_t* A; const bf16_t* Bt; int M, N, K; };

struct StaticOrder {
    int nM, nN, nwg, G, c;
    __host__ __device__ void init(int M, int N, int G_, int c_) { nM = M / BM; nN = N / BM; nwg = nM * nN; G = G_; c = c_; }
    __host__ __device__ bool next(int i, Unit& u) const {
        const long L = (long)i * G + c; if (L >= nwg) return false;
        int wgid = (int)L; { const int q = nwg / NXCD, r = nwg % NXCD, xcd = wgid % NXCD, off = wgid / NXCD; wgid = (xcd < r ? xcd * (q + 1) : r * (q + 1) + (xcd - r) * q) + off; }
        const int nig = WGM * nN, gid = wgid / nig, fm = gid * WGM, gsz = (nM - fm) < WGM ? (nM - fm) : WGM;
        u.pm = fm + ((wgid % nig) % gsz); u.pn = (wgid % nig) / gsz; return true;
    }
    __device__ __forceinline__ void a_ready(const Unit&) const {}
    __device__ __forceinline__ void done(const Unit&) const {}
};
struct CountedOrder : StaticOrder {
    const unsigned* ready; unsigned need; unsigned* tmo;
    __device__ __forceinline__ void a_ready(const Unit& u) const {
        if (threadIdx.x < 64) {
            const unsigned long long t0 = __builtin_amdgcn_s_memrealtime(); unsigned polls = 0;
            while ((unsigned)__builtin_amdgcn_readfirstlane(__hip_atomic_load(ready + 64 * u.pm, __ATOMIC_RELAXED, __HIP_MEMORY_SCOPE_AGENT)) < need) {
                if ((++polls & 255u) == 0u && __builtin_amdgcn_readfirstlane(__hip_atomic_load(tmo, __ATOMIC_RELAXED, __HIP_MEMORY_SCOPE_AGENT)) != 0u) break;
                if (__builtin_amdgcn_s_memrealtime() - t0 > 2000000ull) {
                    if (threadIdx.x == 0) { unsigned expect = 0u; __hip_atomic_compare_exchange_strong(tmo + 1, &expect, 0x600u | (unsigned)(u.pm & 0xff), __ATOMIC_RELAXED, __ATOMIC_RELAXED, __HIP_MEMORY_SCOPE_AGENT); __hip_atomic_store(tmo, 1u, __ATOMIC_RELAXED, __HIP_MEMORY_SCOPE_AGENT); }
                    break; }
                __builtin_amdgcn_s_sleep(2); }
            __builtin_amdgcn_fence(__ATOMIC_ACQUIRE, "agent");
            asm volatile("s_waitcnt vmcnt(0)" ::: "memory");
        }
#if !defined(BROKEN_HOOK_NO_BARRIER)
        asm volatile("" ::: "memory"); __builtin_amdgcn_s_barrier(); asm volatile("" ::: "memory");
#endif
    }
};

__device__ __forceinline__ unsigned cvt_pk_bf16(float lo, float hi) { unsigned r; asm volatile("v_cvt_pk_bf16_f32 %0, %1, %2" : "=v"(r) : "v"(lo), "v"(hi)); return r; }
typedef float f32x2 __attribute__((ext_vector_type(2)));
__device__ __forceinline__ f32x2 gelu_pk(f32x2 v) {
    const f32x2 av = __builtin_elementwise_abs(v), d = av * 0.2316418882f + 1.0f;
    f32x2 t; t.x = __builtin_amdgcn_rcpf(d.x); t.y = __builtin_amdgcn_rcpf(d.y);
    f32x2 q = t * 0.5307027145f + (-0.7265760135f); q = q * t + 0.7107068705f; q = q * t + (-0.142248368f); q = q * t + 0.127414796f; q = q * t;
    const f32x2 s = (v * v) * (-0.72134752044f);
    f32x2 e; e.x = __builtin_amdgcn_exp2f(s.x); e.y = __builtin_amdgcn_exp2f(s.y);
    const f32x2 m = v * (q * e), r = v - m;
    f32x2 o; o.x = v.x < 0.f ? m.x : r.x; o.y = v.y < 0.f ? m.y : r.y; return o;
}

struct EpiF32 {
    static constexpr bool PERM = false, AFTER_DRAIN = false;
    float* C; int ldc; const float* bias;
    __device__ __forceinline__ void operator()(const f32x4 (&acc)[2][2][4][2], const Unit& u, int wr, int wc, int fr, int fq) const {
        const int row0 = u.pm * BM + wr * 64 + fr, col0 = u.pn * BM + wc * 32 + 4 * fq;
        f32x4 bv[2][2];
#pragma unroll
        for (int bj = 0; bj < 2; ++bj)
#pragma unroll
            for (int n = 0; n < 2; ++n) bv[bj][n] = bias ? *(const f32x4*)(bias + col0 + bj * HALF + n * 16) : (f32x4){0.f, 0.f, 0.f, 0.f};
#pragma unroll
        for (int ai = 0; ai < 2; ++ai)
#pragma unroll
            for (int m = 0; m < 4; ++m) { float* rowp = C + (size_t)(row0 + ai * HALF + m * 16) * ldc + col0;
#pragma unroll
                for (int bj = 0; bj < 2; ++bj)
#pragma unroll
                    for (int n = 0; n < 2; ++n) *(f32x4*)(rowp + bj * HALF + n * 16) = acc[ai][bj][m][n] + bv[bj][n]; }
    }
};
template <int ACT  > struct EpiBf16 {
    static constexpr bool PERM = true, AFTER_DRAIN = false;
    bf16_t* O; int ldc; const float* bias; int split_cols; size_t split_stride;
    __device__ __forceinline__ void operator()(const f32x4 (&acc)[2][2][4][2], const Unit& u, int wr, int wc, int fr, int fq) const {
        const int row0 = u.pm * BM + wr * 64 + fr; int colt = u.pn * BM; bf16_t* base = O;
        if (split_cols) { const int t = colt / split_cols; base += (size_t)t * split_stride; colt -= t * split_cols; }
        const int col0 = colt + wc * 32 + 8 * fq, bcol0 = u.pn * BM + wc * 32 + 8 * fq;
        f32x4 bv[2][2];
#pragma unroll
        for (int bj = 0; bj < 2; ++bj)
#pragma unroll
            for (int n = 0; n < 2; ++n) bv[bj][n] = bias ? *(const f32x4*)(bias + bcol0 + bj * HALF + 4 * n) : (f32x4){0.f, 0.f, 0.f, 0.f};
#pragma unroll
        for (int ai = 0; ai < 2; ++ai)
#pragma unroll
            for (int m = 0; m < 4; ++m) { bf16_t* rowp = base + (size_t)(row0 + ai * HALF + m * 16) * ldc + col0;
#pragma unroll
                for (int bj = 0; bj < 2; ++bj) { f32x4 v0 = acc[ai][bj][m][0] + bv[bj][0], v1 = acc[ai][bj][m][1] + bv[bj][1];
                    if (ACT == 1) { f32x2 a = gelu_pk((f32x2){v0[0], v0[1]}), b = gelu_pk((f32x2){v0[2], v0[3]}), c = gelu_pk((f32x2){v1[0], v1[1]}), d = gelu_pk((f32x2){v1[2], v1[3]});
                        v0 = (f32x4){a.x, a.y, b.x, b.y}; v1 = (f32x4){c.x, c.y, d.x, d.y}; }
                    if (ACT == 2) {
#pragma unroll
                        for (int j = 0; j < 4; ++j) { v0[j] = 0.5f * v0[j] * (1.0f + erff(v0[j] * 0.70710678f)); v1[j] = 0.5f * v1[j] * (1.0f + erff(v1[j] * 0.70710678f)); } }
                    u32x4 w; w.x = cvt_pk_bf16(v0[0], v0[1]); w.y = cvt_pk_bf16(v0[2], v0[3]); w.z = cvt_pk_bf16(v1[0], v1[1]); w.w = cvt_pk_bf16(v1[2], v1[3]);
                    *(u32x4*)(rowp + bj * HALF) = w; } }
    }
};

struct PanelStats {
    unsigned* xbuf;
    unsigned* cnt;
    unsigned* tmo;
    int ntn; float eps;
    unsigned code;
    __device__ __forceinline__ bool run(const f32x4 (&v)[2][2][4][2], const Unit& u, int wr, int wc, int fr, int fq, PG8_LAS unsigned char* lds, int wid, int lane) const {
        typedef float f32x2v __attribute__((ext_vector_type(2)));
        PG8_LAS f32x2v* P = (PG8_LAS f32x2v*)lds;
        PG8_LAS f32x2v* S = (PG8_LAS f32x2v*)(lds + 8192);
        PG8_LAS unsigned* flag = (PG8_LAS unsigned*)(lds + 8192 + 2048);
#pragma unroll
        for (int ai = 0; ai < 2; ++ai)
#pragma unroll
            for (int m = 0; m < 4; ++m) {
                float s = 0.f;
#pragma unroll
                for (int bj = 0; bj < 2; ++bj)
#pragma unroll
                    for (int n = 0; n < 2; ++n) { const f32x4 x = v[ai][bj][m][n]; s += (x[0] + x[1]) + (x[2] + x[3]); }
                s += __shfl_xor(s, 16); s += __shfl_xor(s, 32);
                const float mw = s * (1.0f / 64.0f); float q = 0.f;
#pragma unroll
                for (int bj = 0; bj < 2; ++bj)
#pragma unroll
                    for (int n = 0; n < 2; ++n) { const f32x4 d = v[ai][bj][m][n] - mw; q += (d[0] * d[0] + d[1] * d[1]) + (d[2] * d[2] + d[3] * d[3]); }
                q += __shfl_xor(q, 16); q += __shfl_xor(q, 32);
                if (fq == 0) P[(ai * HALF + wr * 64 + m * 16 + fr) * 4 + wc] = (f32x2v){mw, q};
            }
        asm volatile("s_waitcnt lgkmcnt(0)" ::: "memory"); __builtin_amdgcn_s_barrier(); asm volatile("" ::: "memory");
#if defined(BROKEN_NO_WAIT)
        if (blockIdx.x >= 64) { const long long t0 = clock64(); while (clock64() - t0 < 60000) __builtin_amdgcn_s_sleep(8); }
#endif
        const int row = wid * 32 + (lane & 31);
        if (lane < 32) {
            const f32x2v a = P[row * 4 + 0], b = P[row * 4 + 1], c = P[row * 4 + 2], d = P[row * 4 + 3];
            const float mt = (a.x + b.x + c.x + d.x) * 0.25f;
            const float da = a.x - mt, db = b.x - mt, dc = c.x - mt, dd = d.x - mt;
            const float m2 = (a.y + b.y) + (c.y + d.y) + 64.0f * ((da * da + db * db) + (dc * dc + dd * dd));
            unsigned long long* slot = (unsigned long long*)xbuf + ((size_t)(u.pm * BM + row) * 4 + u.pn);
            __hip_atomic_store(slot, ((unsigned long long)__float_as_uint(m2) << 32) | __float_as_uint(mt), __ATOMIC_RELAXED, __HIP_MEMORY_SCOPE_AGENT);
        }
        asm volatile("s_waitcnt vmcnt(0)" ::: "memory");
        if (lane == 0) __hip_atomic_fetch_add(cnt + 64 * u.pm, 1u, __ATOMIC_RELAXED, __HIP_MEMORY_SCOPE_AGENT);
        if (wid == 0) {
            bool dead = false; const unsigned long long t0 = __builtin_amdgcn_s_memrealtime(); const unsigned want = 8u * (unsigned)ntn;
            for (;;) {
#if defined(BROKEN_NO_WAIT)
                break;
#endif
                if ((unsigned)__builtin_amdgcn_readfirstlane(__hip_atomic_load(cnt + 64 * u.pm, __ATOMIC_RELAXED, __HIP_MEMORY_SCOPE_AGENT)) >= want) break;
                if (__builtin_amdgcn_s_memrealtime() - t0 > 2000000ull) {
                    if (lane == 0) { unsigned expect = 0u; __hip_atomic_compare_exchange_strong(tmo + 1, &expect, code | (unsigned)(u.pm & 0xff), __ATOMIC_RELAXED, __ATOMIC_RELAXED, __HIP_MEMORY_SCOPE_AGENT);
                                     __hip_atomic_store(tmo, 1u, __ATOMIC_RELAXED, __HIP_MEMORY_SCOPE_AGENT); }
                    dead = true; break; }
                __builtin_amdgcn_s_sleep(2);
            }
            __builtin_amdgcn_fence(__ATOMIC_ACQUIRE, "agent");
            if (lane == 0) flag[0] = dead ? 1u : 0u;
        }
        asm volatile("s_waitcnt vmcnt(0) lgkmcnt(0)" ::: "memory"); __builtin_amdgcn_s_barrier(); asm volatile("" ::: "memory");
        const bool bad = flag[0] != 0u;
        if (lane < 32) {
            const unsigned long long* slot = (const unsigned long long*)xbuf + (size_t)(u.pm * BM + row) * 4; float mt[4], m2[4]; float ms = 0.f;
#pragma unroll
            for (int t = 0; t < 4; ++t) { if (t < ntn) { const unsigned long long w = __hip_atomic_load(slot + t, __ATOMIC_RELAXED, __HIP_MEMORY_SCOPE_AGENT); mt[t] = __uint_as_float((unsigned)w); m2[t] = __uint_as_float((unsigned)(w >> 32)); } else { mt[t] = 0.f; m2[t] = 0.f; } ms += mt[t]; }
            const float mean = ms / (float)ntn; float q = 0.f;
#pragma unroll
            for (int t = 0; t < 4; ++t) if (t < ntn) { const float dm = mt[t] - mean; q += m2[t] + 256.0f * dm * dm; }
            S[row] = (f32x2v){mean, 1.0f / sqrtf(q / (256.0f * (float)ntn) + eps)};
        }
        asm volatile("s_waitcnt lgkmcnt(0)" ::: "memory"); __builtin_amdgcn_s_barrier(); asm volatile("" ::: "memory");
        return bad;
    }
};
struct EpiLnRes {
    static constexpr bool PERM = false, AFTER_DRAIN = true;
    const float* base; float* out; int ldc; const float* bias; PanelStats st; unsigned poison;
    __device__ __forceinline__ void refuse(size_t i0, size_t stride, int M, int N) const { const float q = __builtin_nanf(""); for (size_t i = i0; i < (size_t)M * N; i += stride) out[(i / N) * ldc + i % N] = q;
        if (i0 == 0) { unsigned expect = 0u; __hip_atomic_compare_exchange_strong(st.tmo + 1, &expect, 0x7f0u, __ATOMIC_RELAXED, __ATOMIC_RELAXED, __HIP_MEMORY_SCOPE_AGENT); __hip_atomic_store(st.tmo, 1u, __ATOMIC_RELAXED, __HIP_MEMORY_SCOPE_AGENT); } }
    __device__ __forceinline__ void fused(f32x4 (&acc)[2][2][4][2], const Unit& u, int wr, int wc, int fr, int fq, PG8_LAS unsigned char* lds, int wid, int lane) const {
        typedef float f32x2v __attribute__((ext_vector_type(2)));
        const PG8_LAS f32x2v* S = (const PG8_LAS f32x2v*)(lds + 8192);
        const int col0 = u.pn * BM + wc * 32 + 4 * fq;
#pragma unroll
        for (int bj = 0; bj < 2; ++bj)
#pragma unroll
            for (int n = 0; n < 2; ++n) { const f32x4 bv = bias ? *(const f32x4*)(bias + col0 + bj * HALF + n * 16) : (f32x4){0.f, 0.f, 0.f, 0.f};
#pragma unroll
                for (int ai = 0; ai < 2; ++ai)
#pragma unroll
                    for (int m = 0; m < 4; ++m) acc[ai][bj][m][n] += bv; }
        const bool bad = st.run(acc, u, wr, wc, fr, fq, lds, wid, lane) || poison != 0u;
        const float qnan = __builtin_nanf("");
#pragma unroll
        for (int ai = 0; ai < 2; ++ai)
#pragma unroll
            for (int m = 0; m < 4; ++m) { const int r = ai * HALF + wr * 64 + m * 16 + fr; const f32x2v sr = S[r]; const size_t off = (size_t)(u.pm * BM + r) * ldc + col0;
#pragma unroll
                for (int bj = 0; bj < 2; ++bj)
#pragma unroll
                    for (int n = 0; n < 2; ++n) { const f32x4 bs = *(const f32x4*)(base + off + bj * HALF + n * 16); f32x4 o = bs + (acc[ai][bj][m][n] - sr.x) * sr.y;
                        if (bad) o = (f32x4){qnan, qnan, qnan, qnan}; *(f32x4*)(out + off + bj * HALF + n * 16) = o; }
                asm volatile("" ::: "memory"); }
    }
};
struct EpiLnResLn {
    static constexpr bool PERM = false, AFTER_DRAIN = true;
    const float* base; float* out; bf16_t* xn; int ldc; const float* bias; PanelStats st1, st2; unsigned poison;
    __device__ __forceinline__ void refuse(size_t i0, size_t stride, int M, int N) const { const float q = __builtin_nanf(""); for (size_t i = i0; i < (size_t)M * N; i += stride) { const size_t o = (i / N) * ldc + i % N; out[o] = q; xn[o] = (bf16_t)0x7fc0u; }
        if (i0 == 0) { unsigned expect = 0u; __hip_atomic_compare_exchange_strong(st1.tmo + 1, &expect, 0x7f0u, __ATOMIC_RELAXED, __ATOMIC_RELAXED, __HIP_MEMORY_SCOPE_AGENT); __hip_atomic_store(st1.tmo, 1u, __ATOMIC_RELAXED, __HIP_MEMORY_SCOPE_AGENT); } }
    __device__ __forceinline__ void fused(f32x4 (&acc)[2][2][4][2], const Unit& u, int wr, int wc, int fr, int fq, PG8_LAS unsigned char* lds, int wid, int lane) const {
        typedef float f32x2v __attribute__((ext_vector_type(2))); typedef unsigned u32x2v __attribute__((ext_vector_type(2)));
        const PG8_LAS f32x2v* S = (const PG8_LAS f32x2v*)(lds + 8192);
        const int col0 = u.pn * BM + wc * 32 + 4 * fq;
#pragma unroll
        for (int bj = 0; bj < 2; ++bj)
#pragma unroll
            for (int n = 0; n < 2; ++n) { const f32x4 bv = bias ? *(const f32x4*)(bias + col0 + bj * HALF + n * 16) : (f32x4){0.f, 0.f, 0.f, 0.f};
#pragma unroll
                for (int ai = 0; ai < 2; ++ai)
#pragma unroll
                    for (int m = 0; m < 4; ++m) acc[ai][bj][m][n] += bv; }
        bool bad = st1.run(acc, u, wr, wc, fr, fq, lds, wid, lane) || poison != 0u;
        const float qnan = __builtin_nanf("");
#pragma unroll
        for (int ai = 0; ai < 2; ++ai)
#pragma unroll
            for (int m = 0; m < 4; ++m) { const int r = ai * HALF + wr * 64 + m * 16 + fr; const f32x2v sr = S[r]; const size_t off = (size_t)(u.pm * BM + r) * ldc + col0;
#pragma unroll
                for (int bj = 0; bj < 2; ++bj)
#pragma unroll
                    for (int n = 0; n < 2; ++n) { const f32x4 bs = *(const f32x4*)(base + off + bj * HALF + n * 16); acc[ai][bj][m][n] = bs + (acc[ai][bj][m][n] - sr.x) * sr.y; }
                asm volatile("" : "+v"(acc[ai][0][m][0]), "+v"(acc[ai][0][m][1]), "+v"(acc[ai][1][m][0]), "+v"(acc[ai][1][m][1]));
                if (m & 1) asm volatile("" ::: "memory"); }
        const bool bad1 = bad;
        bad = st2.run(acc, u, wr, wc, fr, fq, lds, wid, lane) || bad;
#pragma unroll
        for (int ai = 0; ai < 2; ++ai)
#pragma unroll
            for (int m = 0; m < 4; ++m) { const int r = ai * HALF + wr * 64 + m * 16 + fr; const f32x2v sr = S[r]; const size_t off = (size_t)(u.pm * BM + r) * ldc + col0;
#pragma unroll
                for (int bj = 0; bj < 2; ++bj)
#pragma unroll
                    for (int n = 0; n < 2; ++n) { const f32x4 x1 = acc[ai][bj][m][n]; *(f32x4*)(out + off + bj * HALF + n * 16) = bad1 ? (f32x4){qnan, qnan, qnan, qnan} : x1;
                        const f32x4 o = (x1 - sr.x) * sr.y; u32x2v w; w.x = cvt_pk_bf16(o[0], o[1]); w.y = cvt_pk_bf16(o[2], o[3]);
                        if (bad) { w.x = 0x7fc07fc0u; w.y = 0x7fc07fc0u; } *(u32x2v*)(xn + off + bj * HALF + n * 16) = w; }
                asm volatile("" ::: "memory"); }
    }
};

template <class Epi, class Sched, bool STAMP = false>
__device__ __forceinline__ void gemm_phase(PG8_LAS unsigned char* lds, const Gemm g, const Sched& S, const Epi& E, unsigned long long* stamps) {
    const int tid = threadIdx.x, wid = __builtin_amdgcn_readfirstlane(tid >> 6), lane = tid & 63, wr = wid >> 2, wc = wid & 3, fr = lane & 15, fq = lane >> 4;
    const int K = g.K, nt = K / BK;
    int ts_lo = 0, ts_hi = 0, nts = 0; const unsigned long long rt_entry = STAMP ? (unsigned long long)wall_clock64() : 0ull;
#define PG8_STAMP() do { if (STAMP && wid == 0 && nts < 64) { const unsigned long long _c = (unsigned long long)clock64(); \
        ts_lo = (lane == nts) ? (int)(unsigned)_c : ts_lo; ts_hi = (lane == nts) ? (int)(unsigned)(_c >> 32) : ts_hi; ++nts; } } while (0)
    PG8_STAMP();
    unsigned voffA[2], voffB[2];
#pragma unroll
    for (int i = 0; i < 2; ++i) { int R, C; stage_rc(tid * 16 + i * 8192, R, C); const int Rb = Epi::PERM ? ((R & ~31) + perm32(R & 31)) : R;
        voffA[i] = (unsigned)(R * K + C) * 2u; voffB[i] = (unsigned)(Rb * K + C) * 2u; }
    const size_t kstep = (size_t)(BK * 2);
    const size_t hstep = (size_t)HALF * K * 2;
    const size_t tstep = 2 * hstep;
    const unsigned ldsw = (unsigned)wid * 1024u;
    const int aoff = lds_byte(wr * 64 + fr, fq * 8), boff = lds_byte(wc * 32 + fr, fq * 8);
#define PG8_SA(b, h) (((b) * 2 + (h)) * HTB)
#define PG8_SB(b, h) ((4 + (b) * 2 + (h)) * HTB)
#define PG8_STAGE(bufoff, gbase, voff) do { _Pragma("unroll") for (int _i = 0; _i < 2; ++_i) \
        __builtin_amdgcn_global_load_lds((const unsigned*)((const char*)(gbase) + (voff)[_i]), (PG8_LAS unsigned*)(lds + (bufoff) + ldsw + _i * 8192), 16, 0, 0); } while (0)
#define PG8_LDA(dst, b, h) do { _Pragma("unroll") for (int m = 0; m < 4; ++m) _Pragma("unroll") for (int k = 0; k < 2; ++k) dst[m][k] = *(const PG8_LAS bf16x8*)(lds + PG8_SA(b, h) + aoff + m * 2048 + k * 1024); } while (0)
#define PG8_LDB(dst, b, h) do { _Pragma("unroll") for (int n = 0; n < 2; ++n) _Pragma("unroll") for (int k = 0; k < 2; ++k) dst[n][k] = *(const PG8_LAS bf16x8*)(lds + PG8_SB(b, h) + boff + n * 2048 + k * 1024); } while (0)
#define PG8_MMA(ai, bj, At, Bt) do { __builtin_amdgcn_s_setprio(1); _Pragma("unroll") for (int m = 0; m < 4; ++m) _Pragma("unroll") for (int n = 0; n < 2; ++n) _Pragma("unroll") for (int k = 0; k < 2; ++k) \
        acc[ai][bj][m][n] = __builtin_amdgcn_mfma_f32_16x16x32_bf16(Bt[n][k], At[m][k], acc[ai][bj][m][n], 0, 0, 0); __builtin_amdgcn_s_setprio(0); } while (0)
#define PG8_WAIT_V(n) asm volatile("s_waitcnt vmcnt(" #n ")" ::: "memory")
#define PG8_WAIT_L(n) asm volatile("s_waitcnt lgkmcnt(" #n ")" ::: "memory")
#define PG8_BAR __builtin_amdgcn_s_barrier()
#define PG8_SCHED __builtin_amdgcn_sched_barrier(0)
    Unit cur, nxt; int ui = 0;
    if (!S.next(0, cur)) return;
    f32x4 acc[2][2][4][2];
#pragma unroll
    for (int a = 0; a < 2; ++a)
#pragma unroll
        for (int b = 0; b < 2; ++b)
#pragma unroll
            for (int m = 0; m < 4; ++m)
#pragma unroll
                for (int n = 0; n < 2; ++n) acc[a][b][m][n] = (f32x4){0.f, 0.f, 0.f, 0.f};
    bf16x8 At[4][2], B0[2][2], B1[2][2];
    const char* cA = (const char*)g.A + (size_t)cur.pm * tstep; const char* cB = (const char*)g.Bt + (size_t)cur.pn * tstep;
    S.a_ready(cur);
    PG8_STAGE(PG8_SB(0, 0), cB, voffB); PG8_STAGE(PG8_SA(0, 0), cA, voffA); PG8_STAGE(PG8_SB(0, 1), cB + hstep, voffB); PG8_STAGE(PG8_SA(0, 1), cA + hstep, voffA);
    if (wr == 1) PG8_BAR;
    PG8_WAIT_V(4); PG8_BAR;
    PG8_STAGE(PG8_SB(1, 0), cB + kstep, voffB); PG8_STAGE(PG8_SA(1, 0), cA + kstep, voffA); PG8_STAGE(PG8_SB(1, 1), cB + hstep + kstep, voffB);
    PG8_WAIT_V(6); PG8_BAR;
    PG8_STAMP();
    for (;;) {
        const bool has_next = S.next(ui + 1, nxt);
        const char* nA = has_next ? (const char*)g.A + (size_t)nxt.pm * tstep : cA; const char* nB = has_next ? (const char*)g.Bt + (size_t)nxt.pn * tstep : cB;
        for (int t = 0; t < nt; t += 2) {
            const bool last = (t == nt - 2);
            const char* a1 = cA + (size_t)(t + 1) * kstep;
            const char* a2 = last ? nA : cA + (size_t)(t + 2) * kstep; const char* b2 = last ? nB : cB + (size_t)(t + 2) * kstep;
            const char* a3 = a2 + kstep; const char* b3 = b2 + kstep;
            if (last && has_next) S.a_ready(nxt);
            PG8_LDB(B0, 0, 0); PG8_SCHED; PG8_LDA(At, 0, 0); PG8_STAGE(PG8_SA(1, 1), a1 + hstep, voffA);
            PG8_WAIT_L(8); PG8_BAR; PG8_WAIT_L(0); PG8_MMA(0, 0, At, B0); PG8_BAR; PG8_SCHED;
            PG8_LDB(B1, 0, 1); PG8_STAGE(PG8_SB(0, 0), b2, voffB);
            PG8_BAR; PG8_WAIT_L(0); PG8_MMA(0, 1, At, B1); PG8_BAR;
            PG8_LDA(At, 0, 1); PG8_STAGE(PG8_SA(0, 0), a2, voffA);
            PG8_BAR; PG8_WAIT_L(0); PG8_MMA(1, 0, At, B0); PG8_BAR; PG8_SCHED;
            PG8_STAGE(PG8_SB(0, 1), b2 + hstep, voffB);
            PG8_WAIT_V(6); PG8_BAR; PG8_MMA(1, 1, At, B1); PG8_BAR;
            PG8_LDB(B0, 1, 0); PG8_SCHED; PG8_LDA(At, 1, 0); PG8_STAGE(PG8_SA(0, 1), a2 + hstep, voffA);
            PG8_WAIT_L(8); PG8_BAR; PG8_WAIT_L(0); PG8_MMA(0, 0, At, B0); PG8_BAR; PG8_SCHED;
            PG8_LDB(B1, 1, 1); PG8_STAGE(PG8_SB(1, 0), b3, voffB);
            PG8_BAR; PG8_WAIT_L(0); PG8_MMA(0, 1, At, B1); PG8_BAR;
            PG8_LDA(At, 1, 1); PG8_STAGE(PG8_SA(1, 0), a3, voffA);
            PG8_BAR; PG8_WAIT_L(0); PG8_MMA(1, 0, At, B0); PG8_BAR; PG8_SCHED;
            PG8_STAGE(PG8_SB(1, 1), b3 + hstep, voffB);
            PG8_WAIT_V(6); PG8_BAR; PG8_MMA(1, 1, At, B1); PG8_BAR;
        }
        PG8_STAMP();
        if constexpr (!Epi::AFTER_DRAIN) { E(acc, cur, wr, wc, fr, fq); S.done(cur); }
        PG8_STAMP();
        if (!has_next) break;
#pragma unroll
        for (int a = 0; a < 2; ++a)
#pragma unroll
            for (int b = 0; b < 2; ++b)
#pragma unroll
                for (int m = 0; m < 4; ++m)
#pragma unroll
                    for (int n = 0; n < 2; ++n) acc[a][b][m][n] = (f32x4){0.f, 0.f, 0.f, 0.f};
        cur = nxt; cA = nA; cB = nB; ++ui;
    }
    PG8_WAIT_V(0);
    if (wr == 0) PG8_BAR;
    PG8_BAR;
    if constexpr (Epi::AFTER_DRAIN) { E.fused(acc, cur, wr, wc, fr, fq, lds, wid, lane); S.done(cur); }
    PG8_STAMP();
    if (STAMP && wid == 0) { stamps[lane] = lane < nts ? (((unsigned long long)(unsigned)ts_hi << 32) | (unsigned)ts_lo) : 0ull;
        if (lane == 62) stamps[62] = rt_entry; if (lane == 63) stamps[63] = (unsigned long long)wall_clock64(); }
#undef PG8_STAMP
#undef PG8_SA
#undef PG8_SB
#undef PG8_STAGE
#undef PG8_LDA
#undef PG8_LDB
#undef PG8_MMA
#undef PG8_WAIT_V
#undef PG8_WAIT_L
#undef PG8_BAR
#undef PG8_SCHED
}
}

typedef unsigned short bf16_t;
typedef short bf16x8 __attribute__((ext_vector_type(8)));
typedef short s16x4 __attribute__((ext_vector_type(4)));
typedef float f32x4 __attribute__((ext_vector_type(4)));
typedef float f32x16 __attribute__((ext_vector_type(16)));
typedef unsigned u32x4 __attribute__((ext_vector_type(4)));
typedef unsigned u32x2 __attribute__((ext_vector_type(2)));

constexpr int NB = 4, SEQ = 2048, DM = 2048, NTOK = NB * SEQ;
constexpr int INW = 5672, UW = 5888, FFH = 5632;
constexpr float ALPHA = 1.189207115002721f;
constexpr float LN_EPS = 1e-5f;
constexpr int LDS_BYTES = 131072 + 8192;

constexpr size_t CH_BYTES = (size_t)NTOK * 128 * 2;
constexpr size_t WS_U = 0;
constexpr size_t WS_R1 = 45 * CH_BYTES;
constexpr size_t WS_XB = WS_R1;
constexpr size_t WS_WINT = WS_XB + (size_t)NTOK * DM * 2;
constexpr size_t WS_QR = WS_R1;
constexpr size_t WS_DS = WS_QR + 8 * CH_BYTES;
constexpr size_t WS_DECAY = WS_DS + (size_t)16 * 32 * 256 * 128 * 2;
constexpr size_t WS_KCMP = WS_DECAY + (size_t)16 * 32 * 128 * 4;
constexpr size_t WS_MASK = WS_KCMP + (size_t)2 * 4 * 2 * 128 * 128 * 2;
constexpr size_t WS_HB = WS_R1;
constexpr size_t WS_W2T = WS_HB + (size_t)NTOK * DM * 2;
constexpr size_t WS_R2 = WS_R1 + (size_t)NTOK * DM * 2 + (size_t)UW * DM * 2;
constexpr size_t WS_OP = WS_R2;
constexpr size_t WS_W13T = WS_R2;
constexpr size_t WS_A = WS_R2 + (size_t)3 * NTOK * 1024 * 2;
constexpr size_t WS_WOUTT = WS_A + (size_t)NTOK * DM * 2;
constexpr size_t WS_CW1T = WS_WOUTT + (size_t)DM * DM * 2;
constexpr size_t WS_CW2T = WS_CW1T + (size_t)2 * 256 * 4096 * 2;
constexpr size_t WS_C1P = WS_CW2T + (size_t)2 * 128 * 256 * 2;
constexpr size_t WS_ROPE = WS_C1P + (size_t)2 * 16 * 256 * 4;
constexpr size_t WS_END = WS_ROPE + (size_t)2 * 2048 * 16 * 4;

struct Params {
    const float* x; const float* w_in; const float* gate_w2; const float* gate_b2; const float* norm_w;
    const float* ck_pos; const float* ck_w1; const float* ck_w2; const float* cv_pos; const float* cv_w1; const float* cv_w2;
    const float* w_out; const float* ln1_g; const float* ln1_b; const float* ffn_w1; const float* ffn_w3; const float* ffn_w2;
    const float* ln2_g; const float* ln2_b;
    float* out; unsigned char* ws;
};

typedef __bf16 bf16x2_t __attribute__((ext_vector_type(2)));
typedef float f32x2_t __attribute__((ext_vector_type(2)));
__device__ __forceinline__ unsigned cvtpk(float lo, float hi) { f32x2_t v = {lo, hi}; bf16x2_t b = __builtin_convertvector(v, bf16x2_t); return __builtin_bit_cast(unsigned, b); }
__device__ __forceinline__ int otid() { int t = threadIdx.x; asm volatile("" : "+v"(t)); return t; }
__device__ __forceinline__ float bf2f(bf16_t b) { return __uint_as_float(((unsigned)b) << 16); }
__device__ __forceinline__ bf16_t f2bf(float f) { return (bf16_t)(cvtpk(f, 0.f) & 0xffffu); }
__device__ __forceinline__ float bflo(unsigned w) { return __uint_as_float(w << 16); }
__device__ __forceinline__ float bfhi(unsigned w) { return __uint_as_float(w & 0xffff0000u); }
__device__ __forceinline__ float sigmoidf_(float z) { return 1.0f / (1.0f + __expf(-z)); }
#define MFMA32(a, b, c) __builtin_amdgcn_mfma_f32_32x32x16_bf16((a), (b), (c), 0, 0, 0)
__device__ __forceinline__ int crow(int r, int hi) { return (r & 3) + 8 * (r >> 2) + 4 * hi; }
__device__ __forceinline__ bf16_t* uchunk(const Params& p, int c) { return (bf16_t*)(p.ws + WS_U + (size_t)c * CH_BYTES); }

struct EpiU {
    static constexpr bool PERM = true, AFTER_DRAIN = false;
    bf16_t* U;
    __device__ __forceinline__ void operator()(const pg8::f32x4 (&acc)[2][2][4][2], const pg8::Unit& u, int wr, int wc, int fr, int fq) const {
        const int row0 = u.pm * 256 + wr * 64 + fr;
#pragma unroll
        for (int bj = 0; bj < 2; ++bj) {
            const int ch = u.pn * 2 + bj; if (ch >= 45) continue;
            bf16_t* base = U + (size_t)ch * NTOK * 128 + wc * 32 + 8 * fq;
#pragma unroll
            for (int ai = 0; ai < 2; ++ai)
#pragma unroll
                for (int m = 0; m < 4; ++m) {
                    const pg8::f32x4 v0 = acc[ai][bj][m][0], v1 = acc[ai][bj][m][1];
                    u32x4 w; w.x = cvtpk(v0[0], v0[1]); w.y = cvtpk(v0[2], v0[3]); w.z = cvtpk(v1[0], v1[1]); w.w = cvtpk(v1[2], v1[3]);
                    *(u32x4*)(base + (size_t)(row0 + ai * 128 + m * 16) * 128) = w; }
        }
    }
};
struct EpiRes {
    static constexpr bool PERM = false, AFTER_DRAIN = false;
    const float* R; float* out;
    __device__ __forceinline__ void operator()(const pg8::f32x4 (&acc)[2][2][4][2], const pg8::Unit& u, int wr, int wc, int fr, int fq) const {
        const int row0 = u.pm * 256 + wr * 64 + fr, col0 = u.pn * 256 + wc * 32 + 4 * fq;
#pragma unroll
        for (int ai = 0; ai < 2; ++ai)
#pragma unroll
            for (int m = 0; m < 4; ++m) { const size_t off = (size_t)(row0 + ai * 128 + m * 16) * DM + col0;
#pragma unroll
                for (int bj = 0; bj < 2; ++bj)
#pragma unroll
                    for (int n = 0; n < 2; ++n) { const pg8::f32x4 r = *(const pg8::f32x4*)(R + off + bj * 128 + n * 16);
                        *(pg8::f32x4*)(out + off + bj * 128 + n * 16) = r * ALPHA + acc[ai][bj][m][n]; } }
    }
};
struct EpiGlu {
    static constexpr bool PERM = true, AFTER_DRAIN = false;
    bf16_t* T;
    __device__ __forceinline__ void operator()(const pg8::f32x4 (&acc)[2][2][4][2], const pg8::Unit& u, int wr, int wc, int fr, int fq) const {
        const int row0 = u.pm * 256 + wr * 64 + fr, col0 = u.pn * 128 + wc * 32 + 8 * fq;
#pragma unroll
        for (int ai = 0; ai < 2; ++ai)
#pragma unroll
            for (int m = 0; m < 4; ++m) {
                float t[8];
#pragma unroll
                for (int n = 0; n < 2; ++n)
#pragma unroll
                    for (int j = 0; j < 4; ++j) { const float a = acc[ai][0][m][n][j], b = acc[ai][1][m][n][j]; t[n * 4 + j] = a * b / (1.0f + __expf(-a)); }
                u32x4 w; w.x = cvtpk(t[0], t[1]); w.y = cvtpk(t[2], t[3]); w.z = cvtpk(t[4], t[5]); w.w = cvtpk(t[6], t[7]);
                *(u32x4*)(T + (size_t)(row0 + ai * 128 + m * 16) * FFH + col0) = w; }
    }
};

__device__ __forceinline__ void tr_tile(const float* src, int ld, int sc, bf16_t* dst, int dstK, int n0, int k0, float* tile) {
    const int tid = otid(), lane = tid & 63, w = __builtin_amdgcn_readfirstlane(tid >> 6);
#pragma unroll
    for (int i = 0; i < 8; ++i) { const int k = w * 8 + i; tile[k * 65 + lane] = sc >= 0 ? src[(size_t)(k0 + k) * ld + sc] : 0.f; }
    __syncthreads();
    const int n = tid >> 3, k8 = (tid & 7) * 8;
    float v[8];
#pragma unroll
    for (int i = 0; i < 8; ++i) v[i] = tile[(k8 + i) * 65 + n];
    u32x4 w4; w4.x = cvtpk(v[0], v[1]); w4.y = cvtpk(v[2], v[3]); w4.z = cvtpk(v[4], v[5]); w4.w = cvtpk(v[6], v[7]);
    *(u32x4*)(dst + (size_t)(n0 + n) * dstK + k0 + k8) = w4;
    __syncthreads();
}
__device__ __forceinline__ int win_col(int n) {
    const int c = n >> 7, r = n & 127;
    if (c < 24) return n;
    if (c < 44) return 3088 + (c - 24) * 128 + r;
    if (c == 44) { if (r < 16) return 3072 + r; if (r < 40) return 5648 + (r - 16); }
    return -1;
}
__constant__ float ROPE_INV[16] = {1.000000000e+00f, 4.403665960e-01f, 1.939227432e-01f, 8.539710194e-02f, 3.760603070e-02f, 1.656043902e-02f, 7.292664610e-03f, 3.211445874e-03f,
                                   1.414213562e-03f, 6.227723788e-04f, 2.742481884e-04f, 1.207697351e-04f, 5.318296098e-05f, 2.341999971e-05f, 1.031338616e-05f, 4.541670478e-06f};

__device__ void transpose_w13(const Params& p, float* tile) {
    bf16_t* dst = (bf16_t*)(p.ws + WS_W13T);
    const int lane = otid() & 63;
    for (int it = blockIdx.x; it < 176 * 32; it += gridDim.x) { const int nt = it >> 5, kt = it & 31; const int n0 = nt * 64;
        const int pn = n0 >> 8, r = n0 & 255, which = r >> 7, j0 = pn * 128 + (r & 127);
        tr_tile(which ? p.ffn_w3 : p.ffn_w1, FFH, j0 + lane, dst, DM, n0, kt * 64, tile); }
}
__device__ void transpose_w2(const Params& p, float* tile) {
    bf16_t* dst = (bf16_t*)(p.ws + WS_W2T);
    const int lane = otid() & 63;
    for (int it = blockIdx.x; it < 32 * 88; it += gridDim.x) { const int nt = it / 88, kt = it % 88;
        tr_tile(p.ffn_w2, DM, nt * 64 + lane, dst, FFH, nt * 64, kt * 64, tile); }
}

__device__ void phase_convert(const Params& p, unsigned char* lds) {
    float* tile = (float*)lds;
    const int tid = otid(), lane = tid & 63;
    { const f32x4* xs = (const f32x4*)p.x; u32x2* xd = (u32x2*)(p.ws + WS_XB);
      for (size_t i = (size_t)blockIdx.x * 512 + tid; i < (size_t)NTOK * DM / 4; i += (size_t)gridDim.x * 512) { const f32x4 v = xs[i]; u32x2 w; w.x = cvtpk(v[0], v[1]); w.y = cvtpk(v[2], v[3]); xd[i] = w; } }
    { bf16_t* dst = (bf16_t*)(p.ws + WS_WINT);
      for (int it = blockIdx.x; it < 92 * 32; it += gridDim.x) { const int nt = it >> 5, kt = it & 31; tr_tile(p.w_in, INW, win_col(nt * 64 + lane), dst, DM, nt * 64, kt * 64, tile); } }
    { bf16_t* dst = (bf16_t*)(p.ws + WS_WOUTT);
      for (int it = blockIdx.x; it < 32 * 32; it += gridDim.x) { const int nt = it >> 5, kt = it & 31; tr_tile(p.w_out, DM, nt * 64 + lane, dst, DM, nt * 64, kt * 64, tile); } }
    for (int kv = 0; kv < 2; ++kv) {
        const float* w1 = kv ? p.cv_w1 : p.ck_w1; const float* w2 = kv ? p.cv_w2 : p.ck_w2;
        bf16_t* d1 = (bf16_t*)(p.ws + WS_CW1T) + (size_t)kv * 256 * 4096; bf16_t* d2 = (bf16_t*)(p.ws + WS_CW2T) + (size_t)kv * 128 * 256;
        for (int it = blockIdx.x; it < 4 * 64; it += gridDim.x) { const int nt = it >> 6, kt = it & 63; tr_tile(w1, 256, nt * 64 + lane, d1, 4096, nt * 64, kt * 64, tile); }
        for (int it = blockIdx.x; it < 2 * 4; it += gridDim.x) { const int nt = it >> 2, kt = it & 3; tr_tile(w2, 128, nt * 64 + lane, d2, 256, nt * 64, kt * 64, tile); }
    }
    for (int it = blockIdx.x; it < 32; it += gridDim.x) {
        const int kv = it >> 4, part = it & 15; const float* w1 = kv ? p.cv_w1 : p.ck_w1; const float* pos = kv ? p.cv_pos : p.ck_pos;
        const int j = tid & 255, half = tid >> 8; float s = 0.f;
        for (int i = 0; i < 128; ++i) { const int row = part * 256 + half * 128 + i; s += pos[row] * w1[(size_t)row * 256 + j]; }
        __syncthreads(); tile[tid] = s; __syncthreads();
        if (tid < 256) ((float*)(p.ws + WS_C1P))[(kv * 16 + part) * 256 + j] = tile[tid] + tile[tid + 256];
        __syncthreads();
    }
    { float* rc = (float*)(p.ws + WS_ROPE); float* rs = rc + 2048 * 16;
      for (int i = blockIdx.x * 512 + tid; i < 2048 * 16; i += gridDim.x * 512) { const int pos = i >> 4, k = i & 15;
          const float ang = (float)pos * ROPE_INV[k]; const double rev = (double)ang * 0.15915494309189535; const float fr = (float)(rev - rint(rev));
          rc[i] = __builtin_amdgcn_cosf(fr); rs[i] = __builtin_amdgcn_sinf(fr); } }
}

__device__ void phase_rope(const Params& p) {
    const float* rc = (const float*)(p.ws + WS_ROPE); const float* rs = rc + 2048 * 16;
    for (int idx = blockIdx.x * 512 + otid(); idx < 12 * NTOK; idx += gridDim.x * 512) {
        const int kind = idx / NTOK, tok = idx - kind * NTOK, pos = tok & (SEQ - 1);
        const bf16_t* src; bf16_t* dst;
        if (kind < 8) { src = uchunk(p, 24 + kind) + (size_t)tok * 128; dst = (bf16_t*)(p.ws + WS_QR) + ((size_t)kind * NTOK + tok) * 128; }
        else { const int c = kind < 10 ? 36 + (kind - 8) : 40 + (kind - 10); dst = uchunk(p, c) + (size_t)tok * 128; src = dst; }
        u32x4 a0 = ((const u32x4*)src)[0], a1 = ((const u32x4*)src)[1], b0 = ((const u32x4*)src)[2], b1 = ((const u32x4*)src)[3];
        unsigned xa[8] = {a0.x, a0.y, a0.z, a0.w, a1.x, a1.y, a1.z, a1.w}, xb[8] = {b0.x, b0.y, b0.z, b0.w, b1.x, b1.y, b1.z, b1.w};
        unsigned oa[8], ob[8];
#pragma unroll
        for (int i = 0; i < 8; ++i) {
            const float c0 = rc[pos * 16 + 2 * i], c1 = rc[pos * 16 + 2 * i + 1], s0 = rs[pos * 16 + 2 * i], s1 = rs[pos * 16 + 2 * i + 1];
            const float x10 = bflo(xa[i]), x11 = bfhi(xa[i]), x20 = bflo(xb[i]), x21 = bfhi(xb[i]);
            oa[i] = cvtpk(x10 * c0 - x20 * s0, x11 * c1 - x21 * s1);
            ob[i] = cvtpk(x20 * c0 + x10 * s0, x21 * c1 + x11 * s1);
        }
        ((u32x4*)dst)[0] = (u32x4){oa[0], oa[1], oa[2], oa[3]}; ((u32x4*)dst)[1] = (u32x4){oa[4], oa[5], oa[6], oa[7]};
        ((u32x4*)dst)[2] = (u32x4){ob[0], ob[1], ob[2], ob[3]}; ((u32x4*)dst)[3] = (u32x4){ob[4], ob[5], ob[6], ob[7]};
        if (kind < 8) {
#pragma unroll
            for (int i = 4; i < 16; ++i) ((u32x4*)dst)[i] = ((const u32x4*)src)[i];
        }
    }
}

__device__ __forceinline__ void gla_bc(const Params& p, int b, int h, int n, float* glr  , float* tot  , float (&bc)[16], float& blast) {
    const int tid = otid(), d = tid & 127, tq = tid >> 7;
    const size_t tok0 = (size_t)b * SEQ + n * 64;
    const bf16_t* u44 = uchunk(p, 44);
    __syncthreads();
    for (int i = tid; i < 1024; i += 512) glr[i] = bf2f(u44[(tok0 + (i >> 4)) * 128 + (i & 15)]);
    float w2[16];
#pragma unroll
    for (int r = 0; r < 16; ++r) w2[r] = p.gate_w2[r * 512 + h * 128 + d];
    const float bias = p.gate_b2[h * 128 + d];
    __syncthreads();
    float run = 0.f;
#pragma unroll
    for (int tt = 0; tt < 16; ++tt) { const int t = tq * 16 + tt; float z = bias;
#pragma unroll
        for (int r = 0; r < 16; ++r) z += glr[t * 16 + r] * w2[r];
        const float ls = fminf(z, 0.f) - log1pf(__expf(-fabsf(z)));
        run += ls * (1.0f / 16.0f); bc[tt] = run; }
    tot[tq * 128 + d] = run;
    __syncthreads();
    float off = 0.f, all = 0.f;
#pragma unroll
    for (int q = 0; q < 4; ++q) { const float v = tot[q * 128 + d]; all += v; if (q < tq) off += v; }
#pragma unroll
    for (int tt = 0; tt < 16; ++tt) bc[tt] += off;
    blast = all;
}
__device__ __forceinline__ void gla_stage_vT(const Params& p, int h, size_t tok0, bf16_t* vT) {
    const int tid = otid();
    for (int pc = tid; pc < 2048; pc += 512) { const int t = pc >> 5, e8 = (pc & 31) * 8;
        const bf16_t* src = uchunk(p, 8 + 2 * h + (e8 >> 7)) + (tok0 + t) * 128 + (e8 & 127);
        const u32x4 w = *(const u32x4*)src; const unsigned ww[4] = {w.x, w.y, w.z, w.w};
#pragma unroll
        for (int i = 0; i < 4; ++i) { vT[(e8 + 2 * i) * 72 + t] = (bf16_t)(ww[i] & 0xffffu); vT[(e8 + 2 * i + 1) * 72 + t] = (bf16_t)(ww[i] >> 16); } }
}
__device__ void gla_g1(const Params& p, int item, unsigned char* lds) {
    const int bh = item >> 5, n = item & 31, b = bh >> 2, h = bh & 3;
    const int tid = otid(), d = tid & 127, tq = tid >> 7, wid = __builtin_amdgcn_readfirstlane(tid >> 6), lane = tid & 63, r32 = lane & 31, hi = lane >> 5;
    float* glr = (float*)lds; float* tot = (float*)(lds + 4096);
    bf16_t* ksT = (bf16_t*)(lds + 8192); bf16_t* vT = (bf16_t*)(lds + 8192 + 128 * 72 * 2);
    const size_t tok0 = (size_t)b * SEQ + n * 64;
    float bc[16], blast; gla_bc(p, b, h, n, glr, tot, bc, blast);
    const bf16_t* kc = uchunk(p, 4 + h);
#pragma unroll
    for (int tt = 0; tt < 16; ++tt) { const int t = tq * 16 + tt; const float kv = bf2f(kc[(tok0 + t) * 128 + d]); ksT[d * 72 + t] = f2bf(kv * __expf(blast - bc[tt])); }
    if (tq == 0) ((float*)(p.ws + WS_DECAY))[(size_t)item * 128 + d] = __expf(blast);
    gla_stage_vT(p, h, tok0, vT);
    __syncthreads();
    f32x16 acc[4] = {};
#pragma unroll
    for (int ks = 0; ks < 4; ++ks) { const bf16x8 a = *(const bf16x8*)(vT + (wid * 32 + r32) * 72 + ks * 16 + hi * 8);
#pragma unroll
        for (int db = 0; db < 4; ++db) { const bf16x8 bb = *(const bf16x8*)(ksT + (db * 32 + r32) * 72 + ks * 16 + hi * 8); acc[db] = MFMA32(a, bb, acc[db]); } }
    bf16_t* ds = (bf16_t*)(p.ws + WS_DS) + (size_t)item * 256 * 128;
#pragma unroll
    for (int db = 0; db < 4; ++db)
#pragma unroll
        for (int r = 0; r < 16; ++r) ds[(wid * 32 + crow(r, hi)) * 128 + db * 32 + r32] = f2bf(acc[db][r]);
}
__device__ void phase_gla_scan(const Params& p) {
    bf16_t* ds = (bf16_t*)(p.ws + WS_DS); const float* dec = (const float*)(p.ws + WS_DECAY);
    for (int idx = blockIdx.x * 512 + otid(); idx < 16 * 256 * 16; idx += gridDim.x * 512) {
        const int bh = idx >> 12, e = (idx >> 4) & 255, d8 = (idx & 15) * 8;
        float st[8] = {0.f, 0.f, 0.f, 0.f, 0.f, 0.f, 0.f, 0.f};
#pragma unroll 4
        for (int n = 0; n < 32; ++n) {
            u32x4* ptr = (u32x4*)(ds + ((size_t)(bh * 32 + n) * 256 + e) * 128 + d8);
            const u32x4 w = *ptr; const f32x4 dc0 = *(const f32x4*)(dec + (size_t)(bh * 32 + n) * 128 + d8), dc1 = *(const f32x4*)(dec + (size_t)(bh * 32 + n) * 128 + d8 + 4);
            u32x4 o; o.x = cvtpk(st[0], st[1]); o.y = cvtpk(st[2], st[3]); o.z = cvtpk(st[4], st[5]); o.w = cvtpk(st[6], st[7]);
            *ptr = o;
            st[0] = dc0[0] * st[0] + bflo(w.x); st[1] = dc0[1] * st[1] + bfhi(w.x); st[2] = dc0[2] * st[2] + bflo(w.y); st[3] = dc0[3] * st[3] + bfhi(w.y);
            st[4] = dc1[0] * st[4] + bflo(w.z); st[5] = dc1[1] * st[5] + bfhi(w.z); st[6] = dc1[2] * st[6] + bflo(w.w); st[7] = dc1[3] * st[7] + bfhi(w.w);
        }
    }
}
__device__ void gla_g3(const Params& p, int item, unsigned char* lds) {
    const int bh = item >> 5, n = item & 31, b = bh >> 2, h = bh & 3;
    const int tid = otid(), d = tid & 127, tq = tid >> 7, wid = __builtin_amdgcn_readfirstlane(tid >> 6), lane = tid & 63, r32 = lane & 31, hi = lane >> 5;
    float* glr = (float*)lds; float* tot = (float*)(lds + 4096);
    bf16_t* qd = (bf16_t*)(lds + 8192); bf16_t* ki = (bf16_t*)(lds + 25600); bf16_t* vT = (bf16_t*)(lds + 43008); bf16_t* at = (bf16_t*)(lds + 79872);
    float* ol = (float*)(lds + 8192);
    const size_t tok0 = (size_t)b * SEQ + n * 64;
    float bc[16], blast; gla_bc(p, b, h, n, glr, tot, bc, blast);
    const bf16_t* qc = uchunk(p, h); const bf16_t* kc = uchunk(p, 4 + h);
#pragma unroll
    for (int tt = 0; tt < 16; ++tt) { const int t = tq * 16 + tt; const float e = __expf(bc[tt]);
        qd[t * 136 + d] = f2bf(bf2f(qc[(tok0 + t) * 128 + d]) * 0.08838834764831845f * e);
        ki[t * 136 + d] = f2bf(bf2f(kc[(tok0 + t) * 128 + d]) / e); }
    gla_stage_vT(p, h, tok0, vT);
    __syncthreads();
    const int ib = wid & 1, eb = (wid >> 1) * 2;
    f32x16 acc[2] = {};
    { const bf16_t* sp = (const bf16_t*)(p.ws + WS_DS) + (size_t)item * 256 * 128;
#pragma unroll
      for (int ks = 0; ks < 8; ++ks) { const bf16x8 a = *(const bf16x8*)(qd + (ib * 32 + r32) * 136 + ks * 16 + hi * 8);
#pragma unroll
          for (int x = 0; x < 2; ++x) { const bf16x8 bb = *(const bf16x8*)(sp + ((eb + x) * 32 + r32) * 128 + ks * 16 + hi * 8); acc[x] = MFMA32(a, bb, acc[x]); } } }
    if (wid < 4) { const int jb = wid >> 1; f32x16 s = {};
#pragma unroll
        for (int ks = 0; ks < 8; ++ks) { const bf16x8 a = *(const bf16x8*)(qd + (ib * 32 + r32) * 136 + ks * 16 + hi * 8); const bf16x8 bb = *(const bf16x8*)(ki + (jb * 32 + r32) * 136 + ks * 16 + hi * 8); s = MFMA32(a, bb, s); }
#pragma unroll
        for (int r = 0; r < 16; ++r) { const int i = ib * 32 + crow(r, hi), j = jb * 32 + r32; at[i * 72 + j] = f2bf(j <= i ? s[r] : 0.f); } }
    __syncthreads();
#pragma unroll
    for (int ks = 0; ks < 4; ++ks) { const bf16x8 a = *(const bf16x8*)(at + (ib * 32 + r32) * 72 + ks * 16 + hi * 8);
#pragma unroll
        for (int x = 0; x < 2; ++x) { const bf16x8 bb = *(const bf16x8*)(vT + ((eb + x) * 32 + r32) * 72 + ks * 16 + hi * 8); acc[x] = MFMA32(a, bb, acc[x]); } }
    __syncthreads();
#pragma unroll
    for (int x = 0; x < 2; ++x)
#pragma unroll
        for (int r = 0; r < 16; ++r) ol[(ib * 32 + crow(r, hi)) * 256 + (eb + x) * 32 + r32] = acc[x][r];
    __syncthreads();
    { const int row = tid >> 3, seg = tid & 7; const float* orow = ol + row * 256 + seg * 32; float ss = 0.f;
#pragma unroll
      for (int i = 0; i < 32; ++i) ss += orow[i] * orow[i];
      ss += __shfl_xor(ss, 1); ss += __shfl_xor(ss, 2); ss += __shfl_xor(ss, 4);
      const float rstd = rsqrtf(ss * (1.0f / 256.0f) + LN_EPS);
      const int e0 = seg * 32; const bf16_t* go = uchunk(p, 16 + 2 * h + (e0 >> 7)) + (tok0 + row) * 128 + (e0 & 127);
      bf16_t* dst = (bf16_t*)(p.ws + WS_A) + (tok0 + row) * DM + h * 256 + e0;
#pragma unroll
      for (int c = 0; c < 4; ++c) { const u32x4 g = ((const u32x4*)go)[c]; const unsigned gw[4] = {g.x, g.y, g.z, g.w}; unsigned ow[4];
#pragma unroll
          for (int i = 0; i < 4; ++i) { const int e = c * 8 + 2 * i; const float g0 = bflo(gw[i]), g1 = bfhi(gw[i]);
              const float v0 = orow[e] * rstd * p.norm_w[e0 + e] * g0 / (1.0f + __expf(-g0)), v1 = orow[e + 1] * rstd * p.norm_w[e0 + e + 1] * g1 / (1.0f + __expf(-g1));
              ow[i] = cvtpk(v0, v1); }
          ((u32x4*)dst)[c] = (u32x4){ow[0], ow[1], ow[2], ow[3]}; } }
    __syncthreads();
}

__device__ void compress_item(const Params& p, int item, unsigned char* lds) {
    const int kv = item >> 5, g = (item >> 4) & 1, rt = item & 15;
    const int tid = otid(), wid = __builtin_amdgcn_readfirstlane(tid >> 6), lane = tid & 63, r32 = lane & 31, hi = lane >> 5;
    const int ksl = wid >> 1, nh = wid & 1;
    const bf16_t* A = uchunk(p, 32 + 2 * kv + g) + (size_t)(rt * 32 + r32) * 2048 + ksl * 1024 + hi * 8;
    const bf16_t* W = (const bf16_t*)(p.ws + WS_CW1T) + (size_t)kv * 256 * 4096 + (size_t)(nh * 128 + r32) * 4096 + ksl * 1024 + hi * 8;
    f32x16 acc[4] = {};
#pragma unroll 2
    for (int ks = 0; ks < 64; ++ks) { const bf16x8 a = *(const bf16x8*)(A + ks * 16);
#pragma unroll
        for (int nb = 0; nb < 4; ++nb) { const bf16x8 bb = *(const bf16x8*)(W + (size_t)nb * 32 * 4096 + ks * 16); acc[nb] = MFMA32(a, bb, acc[nb]); } }
    float* hid = (float*)lds;
    bf16_t* hb = (bf16_t*)(lds + 32768);
    __syncthreads();
    for (int s = 0; s < 4; ++s) {
        if (ksl == s) {
#pragma unroll
            for (int nb = 0; nb < 4; ++nb)
#pragma unroll
                for (int r = 0; r < 16; ++r) { float* q = hid + crow(r, hi) * 256 + nh * 128 + nb * 32 + r32; *q = (s == 0 ? 0.f : *q) + acc[nb][r]; } }
        __syncthreads();
    }
    { const float* c1p = (const float*)(p.ws + WS_C1P) + kv * 16 * 256;
      for (int i = tid; i < 32 * 256; i += 512) { const int j = i & 255; float v = hid[i];
#pragma unroll
          for (int q = 0; q < 16; ++q) v += c1p[q * 256 + j];
          const float u = 0.7978845608028654f * (v + 0.044715f * v * v * v); const float th = 1.0f - 2.0f / (__expf(2.0f * u) + 1.0f);
          hb[(i >> 8) * 264 + j] = f2bf(0.5f * v * (1.0f + th)); } }
    __syncthreads();
    if (wid < 4) { const bf16_t* W2 = (const bf16_t*)(p.ws + WS_CW2T) + (size_t)kv * 128 * 256 + (size_t)(wid * 32 + r32) * 256 + hi * 8; f32x16 o = {};
#pragma unroll
        for (int ks = 0; ks < 16; ++ks) { const bf16x8 a = *(const bf16x8*)(hb + r32 * 264 + ks * 16 + hi * 8); const bf16x8 bb = *(const bf16x8*)(W2 + ks * 16); o = MFMA32(a, bb, o); }
        bf16_t* dst = (bf16_t*)(p.ws + WS_KCMP) + (size_t)kv * 4 * 2 * 128 * 128;
#pragma unroll
        for (int r = 0; r < 16; ++r) { const int m = rt * 32 + crow(r, hi), bb_ = m >> 7, nn = m & 127; dst[((size_t)(bb_ * 2 + g) * 128 + nn) * 128 + wid * 32 + r32] = nn == 127 ? (bf16_t)0 : f2bf(o[r]); } }
    __syncthreads();
}

constexpr int SHM_K = 16384, SHM_V = 16384;
constexpr float SCALE = 0.08838834764831845f;
constexpr float THR = 8.f;
#define KSWZ(row, colB) ((row) * 256 + ((colB) ^ (((row) & 7) << 4)))
#define SBAR() __builtin_amdgcn_sched_barrier(0)
__device__ __forceinline__ int v_st(int k, int c) { const int kk = (k & ~0xC) | ((k & 4) << 1) | ((k & 8) >> 1); return ((kk >> 3) * 4 + (c >> 5)) * 512 + ((kk & 7) * 32 + (c & 31)) * 2; }
__device__ __forceinline__ int v_rd_base(int lane) { return ((lane & 3) << 3) | (((lane >> 2) & 3) << 6) | (((lane >> 4) & 1) << 5) | (((lane >> 5) & 1) << 8); }
constexpr int v_rd_off(int d0, int ks, int half) { return d0 * 512 + ks * 4096 + half * 2048; }
__device__ __forceinline__ void mask_tile(f32x16& p0, f32x16& p1, int dq, unsigned W) {
    const float NEG = -__builtin_inff();
#pragma unroll
    for (int r = 0; r < 16; ++r) { const int c = (r & 3) + 8 * (r >> 2);
        if ((unsigned)(dq - c) >= W) p0[r] = NEG;
        if ((unsigned)(dq - c - 32) >= W) p1[r] = NEG; }
}
__device__ __forceinline__ void partialSM(f32x16& p0, f32x16& p1, float& m_reg, float& mn, float& alpha) {
    float pmax = p0[0];
#pragma unroll
    for (int r = 1; r < 16; ++r) pmax = fmaxf(pmax, p0[r]);
#pragma unroll
    for (int r = 0; r < 16; ++r) pmax = fmaxf(pmax, p1[r]);
    { auto rr = __builtin_amdgcn_permlane32_swap(__float_as_uint(pmax), __float_as_uint(pmax), false, false);
      pmax = fmaxf(__uint_as_float(rr[0]), __uint_as_float(rr[1])); }
    constexpr float C2 = 1.4426950408889634f * SCALE;
    if (__builtin_expect(__all((pmax - m_reg) * SCALE <= THR), 1)) { mn = m_reg; alpha = 1.f; }
    else { mn = fmaxf(m_reg, pmax); alpha = __builtin_amdgcn_exp2f((m_reg - mn) * C2); m_reg = mn; }
    const float mnL = -mn * C2;
#pragma unroll
    for (int r = 0; r < 16; ++r) p0[r] = fmaf(p0[r], C2, mnL);
#pragma unroll
    for (int r = 0; r < 16; ++r) p1[r] = fmaf(p1[r], C2, mnL);
#pragma unroll
    for (int r = 0; r < 16; ++r) p0[r] = __builtin_amdgcn_exp2f(p0[r]);
}
#define PK4(P, B_, OUT) do { unsigned a0 = cvtpk(P[B_+0], P[B_+1]), a1 = cvtpk(P[B_+2], P[B_+3]);                          \
        unsigned b0 = cvtpk(P[B_+4], P[B_+5]), b1 = cvtpk(P[B_+6], P[B_+7]);                                             \
        auto r0 = __builtin_amdgcn_permlane32_swap(a0, b0, false, false); auto r1 = __builtin_amdgcn_permlane32_swap(a1, b1, false, false); \
        u32x4 w = {r0[0], r1[0], r0[1], r1[1]}; OUT = *reinterpret_cast<bf16x8*>(&w); } while (0)
__device__ __forceinline__ void pack_p(const f32x16& p0, const f32x16& p1, bf16x8& pa0, bf16x8& pa1, bf16x8& pa2, bf16x8& pa3) {
    PK4(p0, 0, pa0); PK4(p0, 8, pa1); PK4(p1, 0, pa2); PK4(p1, 8, pa3);
}
__device__ __forceinline__ void finishSM(f32x16& p0, f32x16& p1, float alpha, float& l_reg, bf16x8& pa0, bf16x8& pa1, bf16x8& pa2, bf16x8& pa3) {
#pragma unroll
    for (int r = 0; r < 16; ++r) p1[r] = __builtin_amdgcn_exp2f(p1[r]);
    float ps = 0;
#pragma unroll
    for (int r = 0; r < 16; ++r) ps += p0[r];
#pragma unroll
    for (int r = 0; r < 16; ++r) ps += p1[r];
    { auto rr = __builtin_amdgcn_permlane32_swap(__float_as_uint(ps), __float_as_uint(ps), false, false);
      ps = __uint_as_float(rr[0]) + __uint_as_float(rr[1]); }
    l_reg = l_reg * alpha + ps;
    pack_p(p0, p1, pa0, pa1, pa2, pa3);
}
template <int KB>
__device__ __forceinline__ void qkt(f32x16& p0, f32x16& p1, const char* K_lds, int r32, int hi, const bf16x8* qr) {
    p0 = f32x16{}; p1 = f32x16{};
    const char* kb[4];
#pragma unroll
    for (int dd = 0; dd < 4; ++dd) kb[dd] = K_lds + KB * SHM_K + KSWZ(r32, (dd * 16 + hi * 8) * 2);
#pragma unroll
    for (int d0 = 0; d0 < 8; ++d0) { const char* a = kb[d0 & 3] + (d0 >> 2) * 128;
        bf16x8 b0 = *reinterpret_cast<const bf16x8*>(a);
        bf16x8 b1 = *reinterpret_cast<const bf16x8*>(a + 32 * 256);
        p0 = MFMA32(b0, qr[d0], p0);
        p1 = MFMA32(b1, qr[d0], p1); }
}
template <int VB>
__device__ __forceinline__ void pv_tile(f32x16* o, int vb0, bf16x8 pa0, bf16x8 pa1, bf16x8 pa2, bf16x8 pa3) {
#define TRRD(dst, off) asm volatile("ds_read_b64_tr_b16 %0, %1 offset:%2" : "=&v"(dst) : "v"(vb0), "i"(off) : "memory")
#define PV_D0(d0) do { s16x4 l0, l1, l2, l3, h0, h1, h2, h3; constexpr int b_ = VB * SHM_V + v_rd_off(d0, 0, 0); \
        TRRD(l0, b_); TRRD(h0, b_ + 2048); TRRD(l1, b_ + 4096); TRRD(h1, b_ + 6144); TRRD(l2, b_ + 8192); TRRD(h2, b_ + 10240); TRRD(l3, b_ + 12288); TRRD(h3, b_ + 14336); \
        asm volatile("s_waitcnt lgkmcnt(0)" ::: "memory"); SBAR(); \
        o[d0] = MFMA32(pa0, ((bf16x8){l0[0], l0[1], l0[2], l0[3], h0[0], h0[1], h0[2], h0[3]}), o[d0]);   \
        o[d0] = MFMA32(pa1, ((bf16x8){l1[0], l1[1], l1[2], l1[3], h1[0], h1[1], h1[2], h1[3]}), o[d0]);   \
        o[d0] = MFMA32(pa2, ((bf16x8){l2[0], l2[1], l2[2], l2[3], h2[0], h2[1], h2[2], h2[3]}), o[d0]);   \
        o[d0] = MFMA32(pa3, ((bf16x8){l3[0], l3[1], l3[2], l3[3], h3[0], h3[1], h3[2], h3[3]}), o[d0]); } while (0)
    PV_D0(0); PV_D0(1); PV_D0(2); PV_D0(3);
#undef PV_D0
#undef TRRD
}
__device__ __forceinline__ void stage_kv(const bf16_t* Kg, const bf16_t* Vg, char* K_lds, char* V_lds, int bf) {
    const int tid = otid(), sr = tid >> 4, sc = (tid & 15) * 8;
    const bf16x8 k0 = *(const bf16x8*)(Kg + (size_t)sr * 128 + sc), k1 = *(const bf16x8*)(Kg + (size_t)(32 + sr) * 128 + sc);
    const bf16x8 v0 = *(const bf16x8*)(Vg + (size_t)sr * 128 + sc), v1 = *(const bf16x8*)(Vg + (size_t)(32 + sr) * 128 + sc);
    *(bf16x8*)(K_lds + bf * SHM_K + KSWZ(sr, sc * 2)) = k0; *(bf16x8*)(K_lds + bf * SHM_K + KSWZ(sr, sc * 2) + 32 * 256) = k1;
    *(bf16x8*)(V_lds + bf * SHM_V + v_st(sr, sc)) = v0; *(bf16x8*)(V_lds + bf * SHM_V + v_st(32 + sr, sc)) = v1;
}

__device__ void cmp_item(const Params& p, int item, unsigned char* ldsu) {
    char* lds = (char*)ldsu;
    const int b = item >> 6, g = (item >> 5) & 1, tt = item & 31;
    const int tid = otid(), wid = __builtin_amdgcn_readfirstlane(tid >> 6), lane = tid & 63, r32 = lane & 31, hi = lane >> 5;
    const int hh = wid & 3, sb = wid >> 2, head = g * 4 + hh, t = tt * 64 + sb * 32 + r32;
    const size_t tok = (size_t)b * SEQ + t;
    char* V_lds = lds; char* K_lds = lds + 2 * SHM_V;
    float* wsf = (float*)(lds + 2 * SHM_V + 2 * SHM_K) + wid * 64;
    float* impw = (float*)(lds + 67584); float* imps = (float*)(lds + 67584 + 32768);
    const bf16_t* kc = (const bf16_t*)(p.ws + WS_KCMP) + (size_t)((0 * 4 + b) * 2 + g) * 128 * 128;
    const bf16_t* vc = (const bf16_t*)(p.ws + WS_KCMP) + (size_t)((1 * 4 + b) * 2 + g) * 128 * 128;
    __syncthreads();
    stage_kv(kc, vc, K_lds, V_lds, 0); stage_kv(kc + 64 * 128, vc + 64 * 128, K_lds, V_lds, 1);
    bf16x8 qr[8];
    { const bf16_t* Q = uchunk(p, 24 + head) + tok * 128;
#pragma unroll
      for (int d0 = 0; d0 < 8; ++d0) qr[d0] = *(const bf16x8*)(Q + d0 * 16 + hi * 8); }
    __syncthreads();
    const int nmax = (t - 31) >> 4; const float NEG = -__builtin_inff();
    constexpr float C2 = 1.4426950408889634f * SCALE;
    float* invw = (float*)(lds + 67584 + 32768 + 8192);
    float mx = NEG;
    { f32x16 s0, s1;
      qkt<0>(s0, s1, K_lds, r32, hi, qr);
#pragma unroll
      for (int r = 0; r < 16; ++r) { const int key = (r & 3) + 8 * (r >> 2) + 4 * hi; mx = fmaxf(mx, key <= nmax ? s0[r] : NEG); mx = fmaxf(mx, key + 32 <= nmax ? s1[r] : NEG); }
      SBAR(); qkt<1>(s0, s1, K_lds, r32, hi, qr);
#pragma unroll
      for (int r = 0; r < 16; ++r) { const int key = 64 + (r & 3) + 8 * (r >> 2) + 4 * hi; mx = fmaxf(mx, key <= nmax ? s0[r] : NEG); mx = fmaxf(mx, key + 32 <= nmax ? s1[r] : NEG); } }
    { auto rr = __builtin_amdgcn_permlane32_swap(__float_as_uint(mx), __float_as_uint(mx), false, false); mx = fmaxf(__uint_as_float(rr[0]), __uint_as_float(rr[1])); }
    const float mref = (mx == NEG) ? 0.f : mx, mnL = -mref * C2;
    float sum = 0.f, plPrev = 0.f;
    f32x16 o[4] = {};
    const int vb0 = (int)(uintptr_t)V_lds + v_rd_base(lane);
#define IMP_SRC(P, base) _Pragma("unroll") for (int q = 0; q < 4; ++q) { const float Gq = (P[4 * q] + P[4 * q + 1]) + (P[4 * q + 2] + P[4 * q + 3]); const float pl = __shfl_xor(P[4 * q + 3], 32); \
          impw[(wid * 32 + r32) * 32 + 2 * ((base) + q) + hi] = Gq + (hi ? pl : plPrev); plPrev = pl; }
#define CMP_TILE(TB) do { f32x16 p0, p1; bf16x8 pa0, pa1, pa2, pa3; qkt<TB>(p0, p1, K_lds, r32, hi, qr); \
      _Pragma("unroll") for (int r = 0; r < 16; ++r) { const int key = TB * 64 + (r & 3) + 8 * (r >> 2) + 4 * hi; \
          p0[r] = key <= nmax ? __builtin_amdgcn_exp2f(fmaf(p0[r], C2, mnL)) : 0.f; p1[r] = key + 32 <= nmax ? __builtin_amdgcn_exp2f(fmaf(p1[r], C2, mnL)) : 0.f; sum += p0[r] + p1[r]; } \
      SBAR(); IMP_SRC(p0, TB * 8) IMP_SRC(p1, TB * 8 + 4) SBAR(); \
      pack_p(p0, p1, pa0, pa1, pa2, pa3); pv_tile<TB>(o, vb0, pa0, pa1, pa2, pa3); } while (0)
    SBAR(); CMP_TILE(0); SBAR(); CMP_TILE(1); SBAR();
#undef CMP_TILE
#undef IMP_SRC
    { auto rr = __builtin_amdgcn_permlane32_swap(__float_as_uint(sum), __float_as_uint(sum), false, false); sum = __uint_as_float(rr[0]) + __uint_as_float(rr[1]); }
    const float inv = sum > 0.f ? 1.0f / sum : 0.f;
    if (hi == 0) { wsf[r32] = inv * sigmoidf_(bf2f(uchunk(p, 44)[tok * 128 + 16 + head * 3 + 0])); invw[wid * 32 + r32] = inv; }

    asm volatile("s_waitcnt lgkmcnt(0)" ::: "memory");
    { bf16_t* O = (bf16_t*)(p.ws + WS_OP) + ((size_t)b * SEQ + tt * 64 + sb * 32) * 1024 + head * 128;
#pragma unroll
      for (int r = 0; r < 16; ++r) { const int orow = crow(r, hi); const float gt = wsf[orow];
#pragma unroll
          for (int d0 = 0; d0 < 4; ++d0) O[(size_t)orow * 1024 + d0 * 32 + r32] = f2bf(o[d0][r] * gt); } }
    __syncthreads();
    { const int tokl = tid >> 3, jq = tid & 7, tpos = tt * 64 + tokl, cur = tpos >> 6, sbt = tokl >> 5, rr_ = tokl & 31;
#pragma unroll
      for (int jj = 0; jj < 4; ++jj) { const int j = jq * 4 + jj; float v = 0.f;
#pragma unroll
          for (int h4 = 0; h4 < 4; ++h4) v += impw[((sbt * 4 + h4) * 32 + rr_) * 32 + j] * invw[(sbt * 4 + h4) * 32 + rr_];
          if (j > cur) v = -1e4f;
          if (j == 0 || j == cur || j == cur - 1) v = 1e4f;
          imps[tokl * 32 + j] = v; }
      __syncthreads();
      float vi[32];
#pragma unroll
      for (int i = 0; i < 32; ++i) vi[i] = imps[tokl * 32 + i];
      unsigned word = 0;
#pragma unroll
      for (int jj = 0; jj < 4; ++jj) { const int j = jq * 4 + jj; const float vj = imps[tokl * 32 + j]; int cnt = 0;
#pragma unroll
          for (int i = 0; i < 32; ++i) cnt += (vi[i] > vj || (vi[i] == vj && i < j)) ? 1 : 0;
          if (cnt < 16) word |= 1u << j; }
      word |= __shfl_xor(word, 1); word |= __shfl_xor(word, 2); word |= __shfl_xor(word, 4);
      if (jq == 0) ((unsigned*)(p.ws + WS_MASK))[(size_t)(b * 2 + g) * SEQ + tpos] = word; }
    __syncthreads();
}

template <int MODE>
__device__ void attn_block(const Params& p, int b, int head, int qb, unsigned char* ldsu) {
    char* lds = (char*)ldsu;
    const int tid = otid(), wid = __builtin_amdgcn_readfirstlane(tid >> 6), lane = tid & 63, r32 = lane & 31, hi = lane >> 5;
    const int g = head >> 2, P0 = qb * 256, qlo = P0 + wid * 32, qpos = qlo + r32, qm = qpos - 4 * hi;
    const size_t tokb = (size_t)b * SEQ;
    char* V_lds = lds; char* K_lds = lds + 2 * SHM_V;
    float* wsf = (float*)(lds + 2 * SHM_V + 2 * SHM_K) + wid * 64; float* li_l = wsf; float* al_l = wsf + 32;
    const bf16_t* K = uchunk(p, (MODE ? 36 : 40) + g) + tokb * 128; const bf16_t* V = uchunk(p, (MODE ? 38 : 42) + g) + tokb * 128;
    bf16x8 qr[8];
    { const bf16_t* Q = (const bf16_t*)(p.ws + WS_QR) + ((size_t)head * NTOK + tokb + qpos) * 128;
#pragma unroll
      for (int d0 = 0; d0 < 8; ++d0) qr[d0] = *(const bf16x8*)(Q + d0 * 16 + hi * 8); }
    const unsigned msk = MODE ? ((const unsigned*)(p.ws + WS_MASK))[(size_t)(b * 2 + g) * SEQ + qpos] : 0u;
    const int j_lo = MODE ? 0 : ((P0 - 511 > 0 ? P0 - 511 : 0) >> 6), j_hi = qb * 4 + 4;
    float m_reg = -1e30f, l_reg = 0.f; f32x16 o[4] = {};
    const int vb0 = (int)(uintptr_t)V_lds + v_rd_base(lane);
    for (int j = j_lo; j < j_hi; ++j) {
        const int kb = j * 64;
        __syncthreads();
        stage_kv(K + (size_t)kb * 128, V + (size_t)kb * 128, K_lds, V_lds, 0);
        __syncthreads();
        const bool act = MODE ? (kb <= qlo + 31) : (kb <= qlo + 31 && kb + 63 >= qlo - 511);
        if (!act) continue;
        if (MODE) { if (!__any((int)((msk >> j) & 1u))) continue; }
        f32x16 p0, p1; float mn, alpha; bf16x8 pa0, pa1, pa2, pa3;
        qkt<0>(p0, p1, K_lds, r32, hi, qr);
        if (MODE == 0) { if (kb + 63 > qlo || kb <= qlo + 31 - 512) mask_tile(p0, p1, qm - kb, 512u); }
        else { if (kb + 63 > qlo) mask_tile(p0, p1, qm - kb, 0x7fffffffu);
               if (!((msk >> j) & 1u)) { const float NEG = -__builtin_inff();
#pragma unroll
                   for (int r = 0; r < 16; ++r) { p0[r] = NEG; p1[r] = NEG; } } }
        partialSM(p0, p1, m_reg, mn, alpha);
        if (__any(alpha < 1.f)) { if (hi == 0) al_l[r32] = alpha; asm volatile("s_waitcnt lgkmcnt(0)" ::: "memory");
#pragma unroll
            for (int d_ = 0; d_ < 4; ++d_)
#pragma unroll
                for (int r = 0; r < 16; ++r) o[d_][r] *= al_l[crow(r, hi)]; }
        finishSM(p0, p1, alpha, l_reg, pa0, pa1, pa2, pa3);
        pv_tile<0>(o, vb0, pa0, pa1, pa2, pa3);
    }
    if (hi == 0) { li_l[r32] = l_reg; al_l[r32] = sigmoidf_(bf2f(uchunk(p, 44)[(tokb + qpos) * 128 + 16 + head * 3 + (MODE ? 1 : 2)])); }
    asm volatile("s_waitcnt lgkmcnt(0)" ::: "memory");
    { bf16_t* O = (bf16_t*)(p.ws + WS_OP) + (size_t)(MODE ? 1 : 2) * NTOK * 1024 + (tokb + qlo) * 1024 + head * 128;
#pragma unroll
      for (int r = 0; r < 16; ++r) { const int orow = crow(r, hi); const float sc = al_l[orow] / li_l[orow];
#pragma unroll
          for (int d0 = 0; d0 < 4; ++d0) O[(size_t)orow * 1024 + d0 * 32 + r32] = f2bf(o[d0][r] * sc); } }
    __syncthreads();
}

__device__ void phase_combine(const Params& p) {
    const u32x4* o0 = (const u32x4*)(p.ws + WS_OP); const u32x4* o1 = o0 + (size_t)NTOK * 1024 / 8; const u32x4* o2 = o1 + (size_t)NTOK * 1024 / 8;
    bf16_t* A = (bf16_t*)(p.ws + WS_A);
    for (size_t i = (size_t)blockIdx.x * 512 + otid(); i < (size_t)NTOK * 128; i += (size_t)gridDim.x * 512) {
        const size_t tok = i >> 7; const int c8 = (int)(i & 127) * 8;
        const u32x4 a = o0[i], b = o1[i], c = o2[i]; u32x4 w;
        w.x = cvtpk(bflo(a.x) + bflo(b.x) + bflo(c.x), bfhi(a.x) + bfhi(b.x) + bfhi(c.x));
        w.y = cvtpk(bflo(a.y) + bflo(b.y) + bflo(c.y), bfhi(a.y) + bfhi(b.y) + bfhi(c.y));
        w.z = cvtpk(bflo(a.z) + bflo(b.z) + bflo(c.z), bfhi(a.z) + bfhi(b.z) + bfhi(c.z));
        w.w = cvtpk(bflo(a.w) + bflo(b.w) + bflo(c.w), bfhi(a.w) + bfhi(b.w) + bfhi(c.w));
        *(u32x4*)(A + tok * DM + 1024 + c8) = w;
    }
}

template <bool WRITE_BF>
__device__ void phase_ln(const Params& p, const float* gam, const float* bet) {
    const int wid = __builtin_amdgcn_readfirstlane(otid() >> 6), lane = otid() & 63;
    for (int row = blockIdx.x * 8 + wid; row < NTOK; row += gridDim.x * 8) {
        float* rp = p.out + (size_t)row * DM;
        f32x4 v[8]; float s = 0.f;
#pragma unroll
        for (int i = 0; i < 8; ++i) { v[i] = *(const f32x4*)(rp + (i * 64 + lane) * 4); s += (v[i][0] + v[i][1]) + (v[i][2] + v[i][3]); }
#pragma unroll
        for (int o = 32; o >= 1; o >>= 1) s += __shfl_xor(s, o);
        const float mean = s * (1.0f / DM); float q = 0.f;
#pragma unroll
        for (int i = 0; i < 8; ++i) { const f32x4 d = v[i] - mean; q += (d[0] * d[0] + d[1] * d[1]) + (d[2] * d[2] + d[3] * d[3]); }
#pragma unroll
        for (int o = 32; o >= 1; o >>= 1) q += __shfl_xor(q, o);
        const float rstd = rsqrtf(q * (1.0f / DM) + LN_EPS);
#pragma unroll
        for (int i = 0; i < 8; ++i) { const int c = (i * 64 + lane) * 4; const f32x4 gg = *(const f32x4*)(gam + c), bb = *(const f32x4*)(bet + c);
            const f32x4 y = (v[i] - mean) * rstd * gg + bb; *(f32x4*)(rp + c) = y;
            if (WRITE_BF) { u32x2 w; w.x = cvtpk(y[0], y[1]); w.y = cvtpk(y[2], y[3]); *(u32x2*)((bf16_t*)(p.ws + WS_HB) + (size_t)row * DM + c) = w; } }
    }
}

template <class Epi>
__device__ __forceinline__ void run_gemm(unsigned char* shm, const bf16_t* A, const bf16_t* Bt, int M, int N, int K, const Epi& E) {
    pg8::StaticOrder S; S.init(M, N, (int)gridDim.x, (int)blockIdx.x);
    pg8::Gemm g{A, Bt, M, N, K};
    pg8::gemm_phase<Epi, pg8::StaticOrder, false>((PG8_LAS unsigned char*)shm, g, S, E, nullptr);
    __syncthreads();
}
__device__ void phase_p2(const Params& p, unsigned char* shm) {
    phase_rope(p);
    const int G = gridDim.x, w = blockIdx.x;
    if (G > 64) { if (w < 64) compress_item(p, w, shm); else for (int i = w - 64; i < 512; i += G - 64) gla_g1(p, i, shm); }
    else { for (int i = w; i < 64; i += G) compress_item(p, i, shm); for (int i = w; i < 512; i += G) gla_g1(p, i, shm); }
}
__device__ __forceinline__ bool p4_decode(int i, int& mode, int& qb, int& bh) {
    bh = i & 31;
    if (i < 192) { mode = 1; qb = 7 - (i >> 5); }
    else if (i < 384) { mode = 0; qb = 2 + ((i - 192) >> 5); }
    else if (i < 416) { mode = 1; qb = 1; } else if (i < 448) { mode = 0; qb = 1; } else if (i < 480) { mode = 1; qb = 0; } else { mode = 0; qb = 0; }
    return i < 512;
}
template <int SEL>
__device__ __forceinline__ void p4_loop(const Params& p, unsigned char* shm) {
    const int G = gridDim.x;
    for (int k = 0; k * G < 1024; ++k) {
        const int i = k * G + ((k & 1) ? G - 1 - (int)blockIdx.x : (int)blockIdx.x);
        if (i >= 1024) continue;
        if (SEL == 2) { if (i >= 512) gla_g3(p, i - 512, shm); continue; }
        int mode, qb, bh; if (!p4_decode(i, mode, qb, bh)) continue;
        if (mode != SEL) continue;
        attn_block<SEL>(p, bh >> 3, bh & 7, qb, shm);
    }
}
__device__ void phase_p4(const Params& p, unsigned char* shm) {
    p4_loop<1>(p, shm); p4_loop<0>(p, shm); p4_loop<2>(p, shm);
}
constexpr int NPHASE = 11;
#ifndef SUBSEL
#define SUBSEL 0
#endif
template <int PH>
__device__ __forceinline__ void run_phase(const Params& p, unsigned char* shm) {
    if constexpr (PH == 0) phase_convert(p, shm);
    if constexpr (PH == 1) run_gemm(shm, (const bf16_t*)(p.ws + WS_XB), (const bf16_t*)(p.ws + WS_WINT), NTOK, UW, DM, EpiU{(bf16_t*)(p.ws + WS_U)});
    if constexpr (PH == 2) phase_p2(p, shm);
    if constexpr (PH == 3) { for (int i = blockIdx.x; i < 256; i += gridDim.x) cmp_item(p, i, shm); phase_gla_scan(p); }
    if constexpr (PH == 4) phase_p4(p, shm);
    if constexpr (PH == 5) { phase_combine(p); transpose_w2(p, (float*)shm); }
    if constexpr (PH == 6) { run_gemm(shm, (const bf16_t*)(p.ws + WS_A), (const bf16_t*)(p.ws + WS_WOUTT), NTOK, DM, DM, EpiRes{p.x, p.out}); transpose_w13(p, (float*)shm); }
    if constexpr (PH == 7) phase_ln<true>(p, p.ln1_g, p.ln1_b);
    if constexpr (PH == 8) run_gemm(shm, (const bf16_t*)(p.ws + WS_HB), (const bf16_t*)(p.ws + WS_W13T), NTOK, 2 * FFH, DM, EpiGlu{(bf16_t*)(p.ws + WS_U)});
    if constexpr (PH == 9) run_gemm(shm, (const bf16_t*)(p.ws + WS_U), (const bf16_t*)(p.ws + WS_W2T), NTOK, DM, FFH, EpiRes{p.out, p.out});
    if constexpr (PH == 10) phase_ln<false>(p, p.ln2_g, p.ln2_b);
}
template <int PH, int HI, bool ONE>
__device__ __forceinline__ void run_range(const Params& p, unsigned char* shm) {
    if constexpr (PH < HI) {
        run_phase<PH>(p, shm);
        if constexpr (ONE && PH + 1 < HI) cg::this_grid().sync();
        run_range<PH + 1, HI, ONE>(p, shm);
    }
}
template <int LO, int HI, bool ONE>
__global__ __launch_bounds__(512, 2) void mk(Params p) {
    extern __shared__ __attribute__((aligned(16))) unsigned char shm[];
    run_range<LO, HI, ONE>(p, shm);
}
template <int PH> static void launch_one(int grid, const Params& p, hipStream_t stream) {
    static bool attr = false; if (!attr) { (void)hipFuncSetAttribute((const void*)mk<PH, PH + 1, false>, hipFuncAttributeMaxDynamicSharedMemorySize, LDS_BYTES); attr = true; }
    hipLaunchKernelGGL((mk<PH, PH + 1, false>), dim3(grid), dim3(512), LDS_BYTES, stream, p);
}

#ifndef MK_ONE
#define MK_ONE 0
#endif
extern "C" void kernel_launch(void* const* d_in, const int* in_sizes, int n_in, void* d_out, int out_size, void* d_ws, size_t ws_size, hipStream_t stream) {
    static int grid = 0;
    if (grid == 0) {
        if (n_in != 19 || out_size != NTOK * DM || ws_size < WS_END) { fprintf(stderr, "kernel_launch: unexpected shapes (n_in %d out %d ws %zu need %zu)\n", n_in, out_size, ws_size, (size_t)WS_END); grid = -1; return; }
        int dev = 0, cus = 0, per_cu = 0;
        (void)hipGetDevice(&dev); (void)hipDeviceGetAttribute(&cus, hipDeviceAttributeMultiprocessorCount, dev);
        #if MK_ONE
        (void)hipFuncSetAttribute((const void*)mk<0, NPHASE, true>, hipFuncAttributeMaxDynamicSharedMemorySize, LDS_BYTES);
        if (hipOccupancyMaxActiveBlocksPerMultiprocessor(&per_cu, (const void*)mk<0, NPHASE, true>, 512, LDS_BYTES) != hipSuccess || per_cu < 1) { fprintf(stderr, "kernel_launch: occupancy query says %d blocks per CU\n", per_cu); per_cu = 1; }
#endif
        (void)hipGetLastError();
        if (cus <= 0) cus = 256;
        grid = cus;
    }
    if (grid < 0) return;
    Params p{};
    p.x = (const float*)d_in[0]; p.w_in = (const float*)d_in[1]; p.gate_w2 = (const float*)d_in[2]; p.gate_b2 = (const float*)d_in[3]; p.norm_w = (const float*)d_in[4];
    p.ck_pos = (const float*)d_in[5]; p.ck_w1 = (const float*)d_in[6]; p.ck_w2 = (const float*)d_in[7]; p.cv_pos = (const float*)d_in[8]; p.cv_w1 = (const float*)d_in[9]; p.cv_w2 = (const float*)d_in[10];
    p.w_out = (const float*)d_in[11]; p.ln1_g = (const float*)d_in[12]; p.ln1_b = (const float*)d_in[13]; p.ffn_w1 = (const float*)d_in[14]; p.ffn_w3 = (const float*)d_in[15]; p.ffn_w2 = (const float*)d_in[16];
    p.ln2_g = (const float*)d_in[17]; p.ln2_b = (const float*)d_in[18];
    p.out = (float*)d_out; p.ws = (unsigned char*)d_ws;
#if MK_ONE
    void* args[] = {&p};
    hipError_t e = hipLaunchCooperativeKernel((const void*)mk<0, NPHASE, true>, dim3(grid), dim3(512), args, LDS_BYTES, stream);
    if (e != hipSuccess) fprintf(stderr, "cooperative launch failed: %s (grid %d)\n", hipGetErrorString(e), grid);
#else
    launch_one<0>(grid, p, stream); launch_one<1>(grid, p, stream); launch_one<2>(grid, p, stream); launch_one<3>(grid, p, stream); launch_one<4>(grid, p, stream); launch_one<5>(grid, p, stream);
    launch_one<6>(grid, p, stream); launch_one<7>(grid, p, stream); launch_one<8>(grid, p, stream); launch_one<9>(grid, p, stream); launch_one<10>(grid, p, stream);
#endif
}
```

```cpp
#include <hip/hip_runtime.h>
#include <hip/hip_cooperative_groups.h>
#include <cstdio>
#include <cstdint>
namespace cg = cooperative_groups;
#define MK_ONE 1
namespace pg8 {
#define PG8_LAS __attribute__((address_space(3)))
typedef unsigned short bf16_t;
typedef short bf16x8 __attribute__((ext_vector_type(8)));
typedef float f32x4 __attribute__((ext_vector_type(4)));
typedef unsigned u32x4 __attribute__((ext_vector_type(4)));
constexpr int BM = 256, BK = 64, HALF = 128, HTB = HALF * BK * 2  , STAGE_BYTES = 8 * HTB, NXCD = 8, WGM = 8;

__host__ __device__ __forceinline__ int lds_byte(int r, int c) { const int st = (r >> 4) * 2 + (c >> 5), rr = r & 15, cc = c & 31, ob = rr * 64 + cc * 2; return st * 1024 + (ob ^ (((ob >> 9) & 1) << 5)); }
__host__ __device__ __forceinline__ void stage_rc(int b, int& R, int& C) { const int st = b / 1024, sb = b % 1024, swz = sb ^ (((sb >> 9) & 1) << 5); R = (st >> 1) * 16 + swz / 64; C = (st & 1) * 32 + (swz % 64) / 2; }
__host__ __device__ __forceinline__ int perm32(int rho) { const int n = rho >> 4, i = rho & 15; return 8 * (i >> 2) + 4 * n + (i & 3); }

struct Unit { int pm, pn; };
struct Gemm { const bf16_t* A; const bf16_t* Bt; int M, N, K; };

struct StaticOrder {
    int nM, nN, nwg, G, c;
    __host__ __device__ void init(int M, int N, int G_, int c_) { nM = M / BM; nN = N / BM; nwg = nM * nN; G = G_; c = c_; }
    __host__ __device__ bool next(int i, Unit& u) const {
        const long L = (long)i * G + c; if (L >= nwg) return false;
        int wgid = (int)L; { const int q = nwg / NXCD, r = nwg % NXCD, xcd = wgid % NXCD, off = wgid / NXCD; wgid = (xcd < r ? xcd * (q + 1) : r * (q + 1) + (xcd - r) * q) + off; }
        const int nig = WGM * nN, gid = wgid / nig, fm = gid * WGM, gsz = (nM - fm) < WGM ? (nM - fm) : WGM;
        u.pm = fm + ((wgid % nig) % gsz); u.pn = (wgid % nig) / gsz; return true;
    }
    __device__ __forceinline__ void a_ready(const Unit&) const {}
    __device__ __forceinline__ void done(const Unit&) const {}
};
struct CountedOrder : StaticOrder {
    const unsigned* ready; unsigned need; unsigned* tmo;
    __device__ __forceinline__ void a_ready(const Unit& u) const {
        if (threadIdx.x < 64) {
            const unsigned long long t0 = __builtin_amdgcn_s_memrealtime(); unsigned polls = 0;
            while ((unsigned)__builtin_amdgcn_readfirstlane(__hip_atomic_load(ready + 64 * u.pm, __ATOMIC_RELAXED, __HIP_MEMORY_SCOPE_AGENT)) < need) {
                if ((++polls & 255u) == 0u && __builtin_amdgcn_readfirstlane(__hip_atomic_load(tmo, __ATOMIC_RELAXED, __HIP_MEMORY_SCOPE_AGENT)) != 0u) break;
                if (__builtin_amdgcn_s_memrealtime() - t0 > 2000000ull) {
                    if (threadIdx.x == 0) { unsigned expect = 0u; __hip_atomic_compare_exchange_strong(tmo + 1, &expect, 0x600u | (unsigned)(u.pm & 0xff), __ATOMIC_RELAXED, __ATOMIC_RELAXED, __HIP_MEMORY_SCOPE_AGENT); __hip_atomic_store(tmo, 1u, __ATOMIC_RELAXED, __HIP_MEMORY_SCOPE_AGENT); }
                    break; }
                __builtin_amdgcn_s_sleep(2); }
            __builtin_amdgcn_fence(__ATOMIC_ACQUIRE, "agent");
            asm volatile("s_waitcnt vmcnt(0)" ::: "memory");
        }
#if !defined(BROKEN_HOOK_NO_BARRIER)
        asm volatile("" ::: "memory"); __builtin_amdgcn_s_barrier(); asm volatile("" ::: "memory");
#endif
    }
};

__device__ __forceinline__ unsigned cvt_pk_bf16(float lo, float hi) { unsigned r; asm volatile("v_cvt_pk_bf16_f32 %0, %1, %2" : "=v"(r) : "v"(lo), "v"(hi)); return r; }
typedef float f32x2 __attribute__((ext_vector_type(2)));
__device__ __forceinline__ f32x2 gelu_pk(f32x2 v) {
    const f32x2 av = __builtin_elementwise_abs(v), d = av * 0.2316418882f + 1.0f;
    f32x2 t; t.x = __builtin_amdgcn_rcpf(d.x); t.y = __builtin_amdgcn_rcpf(d.y);
    f32x2 q = t * 0.5307027145f + (-0.7265760135f); q = q * t + 0.7107068705f; q = q * t + (-0.142248368f); q = q * t + 0.127414796f; q = q * t;
    const f32x2 s = (v * v) * (-0.72134752044f);
    f32x2 e; e.x = __builtin_amdgcn_exp2f(s.x); e.y = __builtin_amdgcn_exp2f(s.y);
    const f32x2 m = v * (q * e), r = v - m;
    f32x2 o; o.x = v.x < 0.f ? m.x : r.x; o.y = v.y < 0.f ? m.y : r.y; return o;
}

struct EpiF32 {
    static constexpr bool PERM = false, AFTER_DRAIN = false;
    float* C; int ldc; const float* bias;
    __device__ __forceinline__ void operator()(const f32x4 (&acc)[2][2][4][2], const Unit& u, int wr, int wc, int fr, int fq) const {
        const int row0 = u.pm * BM + wr * 64 + fr, col0 = u.pn * BM + wc * 32 + 4 * fq;
        f32x4 bv[2][2];
#pragma unroll
        for (int bj = 0; bj < 2; ++bj)
#pragma unroll
            for (int n = 0; n < 2; ++n) bv[bj][n] = bias ? *(const f32x4*)(bias + col0 + bj * HALF + n * 16) : (f32x4){0.f, 0.f, 0.f, 0.f};
#pragma unroll
        for (int ai = 0; ai < 2; ++ai)
#pragma unroll
            for (int m = 0; m < 4; ++m) { float* rowp = C + (size_t)(row0 + ai * HALF + m * 16) * ldc + col0;
#pragma unroll
                for (int bj = 0; bj < 2; ++bj)
#pragma unroll
                    for (int n = 0; n < 2; ++n) *(f32x4*)(rowp + bj * HALF + n * 16) = acc[ai][bj][m][n] + bv[bj][n]; }
    }
};
template <int ACT  > struct EpiBf16 {
    static constexpr bool PERM = true, AFTER_DRAIN = false;
    bf16_t* O; int ldc; const float* bias; int split_cols; size_t split_stride;
    __device__ __forceinline__ void operator()(const f32x4 (&acc)[2][2][4][2], const Unit& u, int wr, int wc, int fr, int fq) const {
        const int row0 = u.pm * BM + wr * 64 + fr; int colt = u.pn * BM; bf16_t* base = O;
        if (split_cols) { const int t = colt / split_cols; base += (size_t)t * split_stride; colt -= t * split_cols; }
        const int col0 = colt + wc * 32 + 8 * fq, bcol0 = u.pn * BM + wc * 32 + 8 * fq;
        f32x4 bv[2][2];
#pragma unroll
        for (int bj = 0; bj < 2; ++bj)
#pragma unroll
            for (int n = 0; n < 2; ++n) bv[bj][n] = bias ? *(const f32x4*)(bias + bcol0 + bj * HALF + 4 * n) : (f32x4){0.f, 0.f, 0.f, 0.f};
#pragma unroll
        for (int ai = 0; ai < 2; ++ai)
#pragma unroll
            for (int m = 0; m < 4; ++m) { bf16_t* rowp = base + (size_t)(row0 + ai * HALF + m * 16) * ldc + col0;
#pragma unroll
                for (int bj = 0; bj < 2; ++bj) { f32x4 v0 = acc[ai][bj][m][0] + bv[bj][0], v1 = acc[ai][bj][m][1] + bv[bj][1];
                    if (ACT == 1) { f32x2 a = gelu_pk((f32x2){v0[0], v0[1]}), b = gelu_pk((f32x2){v0[2], v0[3]}), c = gelu_pk((f32x2){v1[0], v1[1]}), d = gelu_pk((f32x2){v1[2], v1[3]});
                        v0 = (f32x4){a.x, a.y, b.x, b.y}; v1 = (f32x4){c.x, c.y, d.x, d.y}; }
                    if (ACT == 2) {
#pragma unroll
                        for (int j = 0; j < 4; ++j) { v0[j] = 0.5f * v0[j] * (1.0f + erff(v0[j] * 0.70710678f)); v1[j] = 0.5f * v1[j] * (1.0f + erff(v1[j] * 0.70710678f)); } }
                    u32x4 w; w.x = cvt_pk_bf16(v0[0], v0[1]); w.y = cvt_pk_bf16(v0[2], v0[3]); w.z = cvt_pk_bf16(v1[0], v1[1]); w.w = cvt_pk_bf16(v1[2], v1[3]);
                    *(u32x4*)(rowp + bj * HALF) = w; } }
    }
};

struct PanelStats {
    unsigned* xbuf;
    unsigned* cnt;
    unsigned* tmo;
    int ntn; float eps;
    unsigned code;
    __device__ __forceinline__ bool run(const f32x4 (&v)[2][2][4][2], const Unit& u, int wr, int wc, int fr, int fq, PG8_LAS unsigned char* lds, int wid, int lane) const {
        typedef float f32x2v __attribute__((ext_vector_type(2)));
        PG8_LAS f32x2v* P = (PG8_LAS f32x2v*)lds;
        PG8_LAS f32x2v* S = (PG8_LAS f32x2v*)(lds + 8192);
        PG8_LAS unsigned* flag = (PG8_LAS unsigned*)(lds + 8192 + 2048);
#pragma unroll
        for (int ai = 0; ai < 2; ++ai)
#pragma unroll
            for (int m = 0; m < 4; ++m) {
                float s = 0.f;
#pragma unroll
                for (int bj = 0; bj < 2; ++bj)
#pragma unroll
                    for (int n = 0; n < 2; ++n) { const f32x4 x = v[ai][bj][m][n]; s += (x[0] + x[1]) + (x[2] + x[3]); }
                s += __shfl_xor(s, 16); s += __shfl_xor(s, 32);
                const float mw = s * (1.0f / 64.0f); float q = 0.f;
#pragma unroll
                for (int bj = 0; bj < 2; ++bj)
#pragma unroll
                    for (int n = 0; n < 2; ++n) { const f32x4 d = v[ai][bj][m][n] - mw; q += (d[0] * d[0] + d[1] * d[1]) + (d[2] * d[2] + d[3] * d[3]); }
                q += __shfl_xor(q, 16); q += __shfl_xor(q, 32);
                if (fq == 0) P[(ai * HALF + wr * 64 + m * 16 + fr) * 4 + wc] = (f32x2v){mw, q};
            }
        asm volatile("s_waitcnt lgkmcnt(0)" ::: "memory"); __builtin_amdgcn_s_barrier(); asm volatile("" ::: "memory");
#if defined(BROKEN_NO_WAIT)
        if (blockIdx.x >= 64) { const long long t0 = clock64(); while (clock64() - t0 < 60000) __builtin_amdgcn_s_sleep(8); }
#endif
        const int row = wid * 32 + (lane & 31);
        if (lane < 32) {
            const f32x2v a = P[row * 4 + 0], b = P[row * 4 + 1], c = P[row * 4 + 2], d = P[row * 4 + 3];
            const float mt = (a.x + b.x + c.x + d.x) * 0.25f;
            const float da = a.x - mt, db = b.x - mt, dc = c.x - mt, dd = d.x - mt;
            const float m2 = (a.y + b.y) + (c.y + d.y) + 64.0f * ((da * da + db * db) + (dc * dc + dd * dd));
            unsigned long long* slot = (unsigned long long*)xbuf + ((size_t)(u.pm * BM + row) * 4 + u.pn);
            __hip_atomic_store(slot, ((unsigned long long)__float_as_uint(m2) << 32) | __float_as_uint(mt), __ATOMIC_RELAXED, __HIP_MEMORY_SCOPE_AGENT);
        }
        asm volatile("s_waitcnt vmcnt(0)" ::: "memory");
        if (lane == 0) __hip_atomic_fetch_add(cnt + 64 * u.pm, 1u, __ATOMIC_RELAXED, __HIP_MEMORY_SCOPE_AGENT);
        if (wid == 0) {
            bool dead = false; const unsigned long long t0 = __builtin_amdgcn_s_memrealtime(); const unsigned want = 8u * (unsigned)ntn;
            for (;;) {
#if defined(BROKEN_NO_WAIT)
                break;
#endif
                if ((unsigned)__builtin_amdgcn_readfirstlane(__hip_atomic_load(cnt + 64 * u.pm, __ATOMIC_RELAXED, __HIP_MEMORY_SCOPE_AGENT)) >= want) break;
                if (__builtin_amdgcn_s_memrealtime() - t0 > 2000000ull) {
                    if (lane == 0) { unsigned expect = 0u; __hip_atomic_compare_exchange_strong(tmo + 1, &expect, code | (unsigned)(u.pm & 0xff), __ATOMIC_RELAXED, __ATOMIC_RELAXED, __HIP_MEMORY_SCOPE_AGENT);
                                     __hip_atomic_store(tmo, 1u, __ATOMIC_RELAXED, __HIP_MEMORY_SCOPE_AGENT); }
                    dead = true; break; }
                __builtin_amdgcn_s_sleep(2);
            }
            __builtin_amdgcn_fence(__ATOMIC_ACQUIRE, "agent");
            if (lane == 0) flag[0] = dead ? 1u : 0u;
        }
        asm volatile("s_waitcnt vmcnt(0) lgkmcnt(0)" ::: "memory"); __builtin_amdgcn_s_barrier(); asm volatile("" ::: "memory");
        const bool bad = flag[0] != 0u;
        if (lane < 32) {
            const unsigned long long* slot = (const unsigned long long*)xbuf + (size_t)(u.pm * BM + row) * 4; float mt[4], m2[4]; float ms = 0.f;
#pragma unroll
            for (int t = 0; t < 4; ++t) { if (t < ntn) { const unsigned long long w = __hip_atomic_load(slot + t, __ATOMIC_RELAXED, __HIP_MEMORY_SCOPE_AGENT); mt[t] = __uint_as_float((unsigned)w); m2[t] = __uint_as_float((unsigned)(w >> 32)); } else { mt[t] = 0.f; m2[t] = 0.f; } ms += mt[t]; }
            const float mean = ms / (float)ntn; float q = 0.f;
#pragma unroll
            for (int t = 0; t < 4; ++t) if (t < ntn) { const float dm = mt[t] - mean; q += m2[t] + 256.0f * dm * dm; }
            S[row] = (f32x2v){mean, 1.0f / sqrtf(q / (256.0f * (float)ntn) + eps)};
        }
        asm volatile("s_waitcnt lgkmcnt(0)" ::: "memory"); __builtin_amdgcn_s_barrier(); asm volatile("" ::: "memory");
        return bad;
    }
};
struct EpiLnRes {
    static constexpr bool PERM = false, AFTER_DRAIN = true;
    const float* base; float* out; int ldc; const float* bias; PanelStats st; unsigned poison;
    __device__ __forceinline__ void refuse(size_t i0, size_t stride, int M, int N) const { const float q = __builtin_nanf(""); for (size_t i = i0; i < (size_t)M * N; i += stride) out[(i / N) * ldc + i % N] = q;
        if (i0 == 0) { unsigned expect = 0u; __hip_atomic_compare_exchange_strong(st.tmo + 1, &expect, 0x7f0u, __ATOMIC_RELAXED, __ATOMIC_RELAXED, __HIP_MEMORY_SCOPE_AGENT); __hip_atomic_store(st.tmo, 1u, __ATOMIC_RELAXED, __HIP_MEMORY_SCOPE_AGENT); } }
    __device__ __forceinline__ void fused(f32x4 (&acc)[2][2][4][2], const Unit& u, int wr, int wc, int fr, int fq, PG8_LAS unsigned char* lds, int wid, int lane) const {
        typedef float f32x2v __attribute__((ext_vector_type(2)));
        const PG8_LAS f32x2v* S = (const PG8_LAS f32x2v*)(lds + 8192);
        const int col0 = u.pn * BM + wc * 32 + 4 * fq;
#pragma unroll
        for (int bj = 0; bj < 2; ++bj)
#pragma unroll
            for (int n = 0; n < 2; ++n) { const f32x4 bv = bias ? *(const f32x4*)(bias + col0 + bj * HALF + n * 16) : (f32x4){0.f, 0.f, 0.f, 0.f};
#pragma unroll
                for (int ai = 0; ai < 2; ++ai)
#pragma unroll
                    for (int m = 0; m < 4; ++m) acc[ai][bj][m][n] += bv; }
        const bool bad = st.run(acc, u, wr, wc, fr, fq, lds, wid, lane) || poison != 0u;
        const float qnan = __builtin_nanf("");
#pragma unroll
        for (int ai = 0; ai < 2; ++ai)
#pragma unroll
            for (int m = 0; m < 4; ++m) { const int r = ai * HALF + wr * 64 + m * 16 + fr; const f32x2v sr = S[r]; const size_t off = (size_t)(u.pm * BM + r) * ldc + col0;
#pragma unroll
                for (int bj = 0; bj < 2; ++bj)
#pragma unroll
                    for (int n = 0; n < 2; ++n) { const f32x4 bs = *(const f32x4*)(base + off + bj * HALF + n * 16); f32x4 o = bs + (acc[ai][bj][m][n] - sr.x) * sr.y;
                        if (bad) o = (f32x4){qnan, qnan, qnan, qnan}; *(f32x4*)(out + off + bj * HALF + n * 16) = o; }
                asm volatile("" ::: "memory"); }
    }
};
struct EpiLnResLn {
    static constexpr bool PERM = false, AFTER_DRAIN = true;
    const float* base; float* out; bf16_t* xn; int ldc; const float* bias; PanelStats st1, st2; unsigned poison;
    __device__ __forceinline__ void refuse(size_t i0, size_t stride, int M, int N) const { const float q = __builtin_nanf(""); for (size_t i = i0; i < (size_t)M * N; i += stride) { const size_t o = (i / N) * ldc + i % N; out[o] = q; xn[o] = (bf16_t)0x7fc0u; }
        if (i0 == 0) { unsigned expect = 0u; __hip_atomic_compare_exchange_strong(st1.tmo + 1, &expect, 0x7f0u, __ATOMIC_RELAXED, __ATOMIC_RELAXED, __HIP_MEMORY_SCOPE_AGENT); __hip_atomic_store(st1.tmo, 1u, __ATOMIC_RELAXED, __HIP_MEMORY_SCOPE_AGENT); } }
    __device__ __forceinline__ void fused(f32x4 (&acc)[2][2][4][2], const Unit& u, int wr, int wc, int fr, int fq, PG8_LAS unsigned char* lds, int wid, int lane) const {
        typedef float f32x2v __attribute__((ext_vector_type(2))); typedef unsigned u32x2v __attribute__((ext_vector_type(2)));
        const PG8_LAS f32x2v* S = (const PG8_LAS f32x2v*)(lds + 8192);
        const int col0 = u.pn * BM + wc * 32 + 4 * fq;
#pragma unroll
        for (int bj = 0; bj < 2; ++bj)
#pragma unroll
            for (int n = 0; n < 2; ++n) { const f32x4 bv = bias ? *(const f32x4*)(bias + col0 + bj * HALF + n * 16) : (f32x4){0.f, 0.f, 0.f, 0.f};
#pragma unroll
                for (int ai = 0; ai < 2; ++ai)
#pragma unroll
                    for (int m = 0; m < 4; ++m) acc[ai][bj][m][n] += bv; }
        bool bad = st1.run(acc, u, wr, wc, fr, fq, lds, wid, lane) || poison != 0u;
        const float qnan = __builtin_nanf("");
#pragma unroll
        for (int ai = 0; ai < 2; ++ai)
#pragma unroll
            for (int m = 0; m < 4; ++m) { const int r = ai * HALF + wr * 64 + m * 16 + fr; const f32x2v sr = S[r]; const size_t off = (size_t)(u.pm * BM + r) * ldc + col0;
#pragma unroll
                for (int bj = 0; bj < 2; ++bj)
#pragma unroll
                    for (int n = 0; n < 2; ++n) { const f32x4 bs = *(const f32x4*)(base + off + bj * HALF + n * 16); acc[ai][bj][m][n] = bs + (acc[ai][bj][m][n] - sr.x) * sr.y; }
                asm volatile("" : "+v"(acc[ai][0][m][0]), "+v"(acc[ai][0][m][1]), "+v"(acc[ai][1][m][0]), "+v"(acc[ai][1][m][1]));
                if (m & 1) asm volatile("" ::: "memory"); }
        const bool bad1 = bad;
        bad = st2.run(acc, u, wr, wc, fr, fq, lds, wid, lane) || bad;
#pragma unroll
        for (int ai = 0; ai < 2; ++ai)
#pragma unroll
            for (int m = 0; m < 4; ++m) { const int r = ai * HALF + wr * 64 + m * 16 + fr; const f32x2v sr = S[r]; const size_t off = (size_t)(u.pm * BM + r) * ldc + col0;
#pragma unroll
                for (int bj = 0; bj < 2; ++bj)
#pragma unroll
                    for (int n = 0; n < 2; ++n) { const f32x4 x1 = acc[ai][bj][m][n]; *(f32x4*)(out + off + bj * HALF + n * 16) = bad1 ? (f32x4){qnan, qnan, qnan, qnan} : x1;
                        const f32x4 o = (x1 - sr.x) * sr.y; u32x2v w; w.x = cvt_pk_bf16(o[0], o[1]); w.y = cvt_pk_bf16(o[2], o[3]);
                        if (bad) { w.x = 0x7fc07fc0u; w.y = 0x7fc07fc0u; } *(u32x2v*)(xn + off + bj * HALF + n * 16) = w; }
                asm volatile("" ::: "memory"); }
    }
};

template <class Epi, class Sched, bool STAMP = false>
__device__ __forceinline__ void gemm_phase(PG8_LAS unsigned char* lds, const Gemm g, const Sched& S, const Epi& E, unsigned long long* stamps) {
    const int tid = threadIdx.x, wid = __builtin_amdgcn_readfirstlane(tid >> 6), lane = tid & 63, wr = wid >> 2, wc = wid & 3, fr = lane & 15, fq = lane >> 4;
    const int K = g.K, nt = K / BK;
    int ts_lo = 0, ts_hi = 0, nts = 0; const unsigned long long rt_entry = STAMP ? (unsigned long long)wall_clock64() : 0ull;
#define PG8_STAMP() do { if (STAMP && wid == 0 && nts < 64) { const unsigned long long _c = (unsigned long long)clock64(); \
        ts_lo = (lane == nts) ? (int)(unsigned)_c : ts_lo; ts_hi = (lane == nts) ? (int)(unsigned)(_c >> 32) : ts_hi; ++nts; } } while (0)
    PG8_STAMP();
    unsigned voffA[2], voffB[2];
#pragma unroll
    for (int i = 0; i < 2; ++i) { int R, C; stage_rc(tid * 16 + i * 8192, R, C); const int Rb = Epi::PERM ? ((R & ~31) + perm32(R & 31)) : R;
        voffA[i] = (unsigned)(R * K + C) * 2u; voffB[i] = (unsigned)(Rb * K + C) * 2u; }
    const size_t kstep = (size_t)(BK * 2);
    const size_t hstep = (size_t)HALF * K * 2;
    const size_t tstep = 2 * hstep;
    const unsigned ldsw = (unsigned)wid * 1024u;
    const int aoff = lds_byte(wr * 64 + fr, fq * 8), boff = lds_byte(wc * 32 + fr, fq * 8);
#define PG8_SA(b, h) (((b) * 2 + (h)) * HTB)
#define PG8_SB(b, h) ((4 + (b) * 2 + (h)) * HTB)
#define PG8_STAGE(bufoff, gbase, voff) do { _Pragma("unroll") for (int _i = 0; _i < 2; ++_i) \
        __builtin_amdgcn_global_load_lds((const unsigned*)((const char*)(gbase) + (voff)[_i]), (PG8_LAS unsigned*)(lds + (bufoff) + ldsw + _i * 8192), 16, 0, 0); } while (0)
#define PG8_LDA(dst, b, h) do { _Pragma("unroll") for (int m = 0; m < 4; ++m) _Pragma("unroll") for (int k = 0; k < 2; ++k) dst[m][k] = *(const PG8_LAS bf16x8*)(lds + PG8_SA(b, h) + aoff + m * 2048 + k * 1024); } while (0)
#define PG8_LDB(dst, b, h) do { _Pragma("unroll") for (int n = 0; n < 2; ++n) _Pragma("unroll") for (int k = 0; k < 2; ++k) dst[n][k] = *(const PG8_LAS bf16x8*)(lds + PG8_SB(b, h) + boff + n * 2048 + k * 1024); } while (0)
#define PG8_MMA(ai, bj, At, Bt) do { __builtin_amdgcn_s_setprio(1); _Pragma("unroll") for (int m = 0; m < 4; ++m) _Pragma("unroll") for (int n = 0; n < 2; ++n) _Pragma("unroll") for (int k = 0; k < 2; ++k) \
        acc[ai][bj][m][n] = __builtin_amdgcn_mfma_f32_16x16x32_bf16(Bt[n][k], At[m][k], acc[ai][bj][m][n], 0, 0, 0); __builtin_amdgcn_s_setprio(0); } while (0)
#define PG8_WAIT_V(n) asm volatile("s_waitcnt vmcnt(" #n ")" ::: "memory")
#define PG8_WAIT_L(n) asm volatile("s_waitcnt lgkmcnt(" #n ")" ::: "memory")
#define PG8_BAR __builtin_amdgcn_s_barrier()
#define PG8_SCHED __builtin_amdgcn_sched_barrier(0)
    Unit cur, nxt; int ui = 0;
    if (!S.next(0, cur)) return;
    f32x4 acc[2][2][4][2];
#pragma unroll
    for (int a = 0; a < 2; ++a)
#pragma unroll
        for (int b = 0; b < 2; ++b)
#pragma unroll
            for (int m = 0; m < 4; ++m)
#pragma unroll
                for (int n = 0; n < 2; ++n) acc[a][b][m][n] = (f32x4){0.f, 0.f, 0.f, 0.f};
    bf16x8 At[4][2], B0[2][2], B1[2][2];
    const char* cA = (const char*)g.A + (size_t)cur.pm * tstep; const char* cB = (const char*)g.Bt + (size_t)cur.pn * tstep;
    S.a_ready(cur);
    PG8_STAGE(PG8_SB(0, 0), cB, voffB); PG8_STAGE(PG8_SA(0, 0), cA, voffA); PG8_STAGE(PG8_SB(0, 1), cB + hstep, voffB); PG8_STAGE(PG8_SA(0, 1), cA + hstep, voffA);
    if (wr == 1) PG8_BAR;
    PG8_WAIT_V(4); PG8_BAR;
    PG8_STAGE(PG8_SB(1, 0), cB + kstep, voffB); PG8_STAGE(PG8_SA(1, 0), cA + kstep, voffA); PG8_STAGE(PG8_SB(1, 1), cB + hstep + kstep, voffB);
    PG8_WAIT_V(6); PG8_BAR;
    PG8_STAMP();
    for (;;) {
        const bool has_next = S.next(ui + 1, nxt);
        const char* nA = has_next ? (const char*)g.A + (size_t)nxt.pm * tstep : cA; const char* nB = has_next ? (const char*)g.Bt + (size_t)nxt.pn * tstep : cB;
        for (int t = 0; t < nt; t += 2) {
            const bool last = (t == nt - 2);
            const char* a1 = cA + (size_t)(t + 1) * kstep;
            const char* a2 = last ? nA : cA + (size_t)(t + 2) * kstep; const char* b2 = last ? nB : cB + (size_t)(t + 2) * kstep;
            const char* a3 = a2 + kstep; const char* b3 = b2 + kstep;
            if (last && has_next) S.a_ready(nxt);
            PG8_LDB(B0, 0, 0); PG8_SCHED; PG8_LDA(At, 0, 0); PG8_STAGE(PG8_SA(1, 1), a1 + hstep, voffA);
            PG8_WAIT_L(8); PG8_BAR; PG8_WAIT_L(0); PG8_MMA(0, 0, At, B0); PG8_BAR; PG8_SCHED;
            PG8_LDB(B1, 0, 1); PG8_STAGE(PG8_SB(0, 0), b2, voffB);
            PG8_BAR; PG8_WAIT_L(0); PG8_MMA(0, 1, At, B1); PG8_BAR;
            PG8_LDA(At, 0, 1); PG8_STAGE(PG8_SA(0, 0), a2, voffA);
            PG8_BAR; PG8_WAIT_L(0); PG8_MMA(1, 0, At, B0); PG8_BAR; PG8_SCHED;
            PG8_STAGE(PG8_SB(0, 1), b2 + hstep, voffB);
            PG8_WAIT_V(6); PG8_BAR; PG8_MMA(1, 1, At, B1); PG8_BAR;
            PG8_LDB(B0, 1, 0); PG8_SCHED; PG8_LDA(At, 1, 0); PG8_STAGE(PG8_SA(0, 1), a2 + hstep, voffA);
            PG8_WAIT_L(8); PG8_BAR; PG8_WAIT_L(0); PG8_MMA(0, 0, At, B0); PG8_BAR; PG8_SCHED;
            PG8_LDB(B1, 1, 1); PG8_STAGE(PG8_SB(1, 0), b3, voffB);
            PG8_BAR; PG8_WAIT_L(0); PG8_MMA(0, 1, At, B1); PG8_BAR;
            PG8_LDA(At, 1, 1); PG8_STAGE(PG8_SA(1, 0), a3, voffA);
            PG8_BAR; PG8_WAIT_L(0); PG8_MMA(1, 0, At, B0); PG8_BAR; PG8_SCHED;
            PG8_STAGE(PG8_SB(1, 1), b3 + hstep, voffB);
            PG8_WAIT_V(6); PG8_BAR; PG8_MMA(1, 1, At, B1); PG8_BAR;
        }
        PG8_STAMP();
        if constexpr (!Epi::AFTER_DRAIN) { E(acc, cur, wr, wc, fr, fq); S.done(cur); }
        PG8_STAMP();
        if (!has_next) break;
#pragma unroll
        for (int a = 0; a < 2; ++a)
#pragma unroll
            for (int b = 0; b < 2; ++b)
#pragma unroll
                for (int m = 0; m < 4; ++m)
#pragma unroll
                    for (int n = 0; n < 2; ++n) acc[a][b][m][n] = (f32x4){0.f, 0.f, 0.f, 0.f};
        cur = nxt; cA = nA; cB = nB; ++ui;
    }
    PG8_WAIT_V(0);
    if (wr == 0) PG8_BAR;
    PG8_BAR;
    if constexpr (Epi::AFTER_DRAIN) { E.fused(acc, cur, wr, wc, fr, fq, lds, wid, lane); S.done(cur); }
    PG8_STAMP();
    if (STAMP && wid == 0) { stamps[lane] = lane < nts ? (((unsigned long long)(unsigned)ts_hi << 32) | (unsigned)ts_lo) : 0ull;
        if (lane == 62) stamps[62] = rt_entry; if (lane == 63) stamps[63] = (unsigned long long)wall_clock64(); }
#undef PG8_STAMP
#undef PG8_SA
#undef PG8_SB
#undef PG8_STAGE
#undef PG8_LDA
#undef PG8_LDB
#undef PG8_MMA
#undef PG8_WAIT_V
#undef PG8_WAIT_L
#undef PG8_BAR
#undef PG8_SCHED
}
}

#define XB_TMO      128
#define XB_XCNT(j)  (256  + 64 * (j))
#define XB_XSUB(j)  (1280 + 64 * (j))
#define XB_XGEN(j)  (2304 + 64 * (j))
#define XB_TOP      3328
#define XB_TOPGEN   3392
#define XCD_BAR_WORDS 3456
#define XB_SPIN_CAP (1u << 18)
#define LAS __attribute__((address_space(3)))

__device__ __forceinline__ unsigned xb_ld(unsigned* p)              { return __hip_atomic_load(p, __ATOMIC_RELAXED, __HIP_MEMORY_SCOPE_AGENT); }
__device__ __forceinline__ unsigned xb_add(unsigned* p, unsigned v) { return __hip_atomic_fetch_add(p, v, __ATOMIC_RELAXED, __HIP_MEMORY_SCOPE_AGENT); }
__device__ __forceinline__ unsigned xb_xcc_id() { return (unsigned)__builtin_amdgcn_s_getreg((3 << 11) | 20) & 0xFu; }
#define XB_SPIN(cond, bar) do { unsigned _sp = 0; while (cond) { __builtin_amdgcn_s_sleep(1); \
    if ((++_sp & 255u) == 0u) { if (xb_ld(&(bar)[XB_TMO])) break; if (_sp > XB_SPIN_CAP) { atomicAdd(&(bar)[XB_TMO], 1u); break; } } } } while (0)

struct XcdBarrier {
    unsigned* bar; unsigned x;
    volatile LAS unsigned* st;
};

__device__ __forceinline__ XcdBarrier xcd_barrier_post(unsigned* bar, volatile LAS unsigned* st) {
    XcdBarrier b; b.bar = bar; b.x = xb_xcc_id(); b.st = st;
    if (threadIdx.x == 0) (void)xb_add(&bar[XB_XCNT(b.x)], 1u);
    return b;
}
__device__ __forceinline__ void xcd_barrier_complete(unsigned* bar, unsigned x, unsigned& nloc, unsigned& nx) {
    const unsigned G = gridDim.x * gridDim.y * gridDim.z;
    unsigned sum, cnt, mine, sp = 0u;
    for (;;) {
        sum = 0u; cnt = 0u; mine = 0u;
#pragma unroll
        for (unsigned j = 0; j < 16; ++j) { const unsigned c = xb_ld(&bar[XB_XCNT(j)]); sum += c; cnt += (c > 0u) ? 1u : 0u; mine = (j == x) ? c : mine; }
        if (sum == G) break;
        __builtin_amdgcn_s_sleep(1);
        if ((++sp & 255u) == 0u) { if (xb_ld(&bar[XB_TMO])) break; if (sp > XB_SPIN_CAP) { atomicAdd(&bar[XB_TMO], 1u); break; } }
    }
    nloc = mine > 0u ? mine : 1u; nx = cnt > 0u ? cnt : 1u;
}

__device__ __forceinline__ void xcd_barrier(const XcdBarrier& b) {
    asm volatile("s_waitcnt vmcnt(0)" ::: "memory");
    __syncthreads();
    if (threadIdx.x == 0) {
        unsigned* bar = b.bar;
        __builtin_amdgcn_s_waitcnt(0);
        unsigned nloc = b.st[0], nx = b.st[1];
        if (nloc == 0u) { xcd_barrier_complete(bar, b.x, nloc, nx); b.st[0] = nloc; b.st[1] = nx; }
        const unsigned old = xb_add(&bar[XB_XSUB(b.x)], 1u);
        const unsigned gen = old / nloc;
        if (old + 1u == (gen + 1u) * nloc) {
            __builtin_amdgcn_fence(__ATOMIC_RELEASE, "agent");
            asm volatile("s_waitcnt vmcnt(0)" ::: "memory");
            const unsigned og = xb_add(&bar[XB_TOP], 1u);
            const unsigned tg = og / nx;
            if (og + 1u == (tg + 1u) * nx) xb_add(&bar[XB_TOPGEN], 1u);
            else XB_SPIN(xb_ld(&bar[XB_TOPGEN]) == tg, bar);
            __builtin_amdgcn_fence(__ATOMIC_ACQUIRE, "agent");
            xb_add(&bar[XB_XGEN(b.x)], 1u);
            asm volatile("s_waitcnt vmcnt(0)" ::: "memory");
        } else {
            XB_SPIN(xb_ld(&bar[XB_XGEN(b.x)]) == gen, bar);
            __builtin_amdgcn_fence(__ATOMIC_ACQUIRE, "agent");
            asm volatile("s_waitcnt vmcnt(0)" ::: "memory");
        }
    }
    __syncthreads();
}


typedef unsigned short bf16_t;
typedef short bf16x8 __attribute__((ext_vector_type(8)));
typedef short s16x4 __attribute__((ext_vector_type(4)));
typedef float f32x4 __attribute__((ext_vector_type(4)));
typedef float f32x16 __attribute__((ext_vector_type(16)));
typedef unsigned u32x4 __attribute__((ext_vector_type(4)));
typedef unsigned u32x2 __attribute__((ext_vector_type(2)));

constexpr int NB = 4, SEQ = 2048, DM = 2048, NTOK = NB * SEQ;
constexpr int INW = 5672, UW = 5888, FFH = 5632;
constexpr float ALPHA = 1.189207115002721f;
constexpr float LN_EPS = 1e-5f;
constexpr int LDS_BYTES = 131072 + 8192;

constexpr size_t CH_BYTES = (size_t)NTOK * 128 * 2;
constexpr size_t WS_U = 0;
constexpr size_t WS_R1 = 45 * CH_BYTES;
constexpr size_t WS_XB = WS_R1;
constexpr size_t WS_WINT = WS_XB + (size_t)NTOK * DM * 2;
constexpr size_t WS_QR = WS_R1;
constexpr size_t WS_DS = WS_QR + 8 * CH_BYTES;
constexpr size_t WS_DECAY = WS_DS + (size_t)16 * 32 * 256 * 128 * 2;
constexpr size_t WS_KCMP = WS_DECAY + (size_t)16 * 32 * 128 * 4;
constexpr size_t WS_MASK = WS_KCMP + (size_t)2 * 4 * 2 * 128 * 128 * 2;
constexpr size_t WS_HB = WS_R1;
constexpr size_t WS_W2T = WS_HB + (size_t)NTOK * DM * 2;
constexpr size_t WS_R2 = WS_R1 + (size_t)NTOK * DM * 2 + (size_t)UW * DM * 2;
constexpr size_t WS_OP = WS_R2;
constexpr size_t WS_W13T = WS_R2;
constexpr size_t WS_A = WS_R2 + (size_t)3 * NTOK * 1024 * 2;
constexpr size_t WS_WOUTT = WS_A + (size_t)NTOK * DM * 2;
constexpr size_t WS_CW1T = WS_WOUTT + (size_t)DM * DM * 2;
constexpr size_t WS_CW2T = WS_CW1T + (size_t)2 * 256 * 4096 * 2;
constexpr size_t WS_C1P = WS_CW2T + (size_t)2 * 128 * 256 * 2;
constexpr size_t WS_ROPE = WS_C1P + (size_t)2 * 16 * 256 * 4;
constexpr size_t WS_BAR = WS_ROPE + (size_t)2 * 2048 * 16 * 4;
constexpr size_t WS_END = WS_BAR + 16384;

struct Params {
    const float* x; const float* w_in; const float* gate_w2; const float* gate_b2; const float* norm_w;
    const float* ck_pos; const float* ck_w1; const float* ck_w2; const float* cv_pos; const float* cv_w1; const float* cv_w2;
    const float* w_out; const float* ln1_g; const float* ln1_b; const float* ffn_w1; const float* ffn_w3; const float* ffn_w2;
    const float* ln2_g; const float* ln2_b;
    float* out; unsigned char* ws;
};

typedef __bf16 bf16x2_t __attribute__((ext_vector_type(2)));
typedef float f32x2_t __attribute__((ext_vector_type(2)));
__device__ __forceinline__ unsigned cvtpk(float lo, float hi) { f32x2_t v = {lo, hi}; bf16x2_t b = __builtin_convertvector(v, bf16x2_t); return __builtin_bit_cast(unsigned, b); }
__device__ __forceinline__ int otid() { int t = threadIdx.x; asm volatile("" : "+v"(t)); return t; }
__device__ __forceinline__ float bf2f(bf16_t b) { return __uint_as_float(((unsigned)b) << 16); }
__device__ __forceinline__ bf16_t f2bf(float f) { return (bf16_t)(cvtpk(f, 0.f) & 0xffffu); }
__device__ __forceinline__ float bflo(unsigned w) { return __uint_as_float(w << 16); }
__device__ __forceinline__ float bfhi(unsigned w) { return __uint_as_float(w & 0xffff0000u); }
__device__ __forceinline__ float sigmoidf_(float z) { return 1.0f / (1.0f + __expf(-z)); }
#define MFMA32(a, b, c) __builtin_amdgcn_mfma_f32_32x32x16_bf16((a), (b), (c), 0, 0, 0)
__device__ __forceinline__ int crow(int r, int hi) { return (r & 3) + 8 * (r >> 2) + 4 * hi; }
__device__ __forceinline__ bf16_t* uchunk(const Params& p, int c) { return (bf16_t*)(p.ws + WS_U + (size_t)c * CH_BYTES); }

struct EpiU {
    static constexpr bool PERM = true, AFTER_DRAIN = false;
    bf16_t* U;
    __device__ __forceinline__ void operator()(const pg8::f32x4 (&acc)[2][2][4][2], const pg8::Unit& u, int wr, int wc, int fr, int fq) const {
        const int row0 = u.pm * 256 + wr * 64 + fr;
#pragma unroll
        for (int bj = 0; bj < 2; ++bj) {
            const int ch = u.pn * 2 + bj; if (ch >= 45) continue;
            bf16_t* base = U + (size_t)ch * NTOK * 128 + wc * 32 + 8 * fq;
#pragma unroll
            for (int ai = 0; ai < 2; ++ai)
#pragma unroll
                for (int m = 0; m < 4; ++m) {
                    const pg8::f32x4 v0 = acc[ai][bj][m][0], v1 = acc[ai][bj][m][1];
                    u32x4 w; w.x = cvtpk(v0[0], v0[1]); w.y = cvtpk(v0[2], v0[3]); w.z = cvtpk(v1[0], v1[1]); w.w = cvtpk(v1[2], v1[3]);
                    *(u32x4*)(base + (size_t)(row0 + ai * 128 + m * 16) * 128) = w; }
        }
    }
};
struct EpiRes {
    static constexpr bool PERM = false, AFTER_DRAIN = false;
    const float* R; float* out;
    __device__ __forceinline__ void operator()(const pg8::f32x4 (&acc)[2][2][4][2], const pg8::Unit& u, int wr, int wc, int fr, int fq) const {
        const int row0 = u.pm * 256 + wr * 64 + fr, col0 = u.pn * 256 + wc * 32 + 4 * fq;
#pragma unroll
        for (int ai = 0; ai < 2; ++ai)
#pragma unroll
            for (int m = 0; m < 4; ++m) { const size_t off = (size_t)(row0 + ai * 128 + m * 16) * DM + col0;
#pragma unroll
                for (int bj = 0; bj < 2; ++bj)
#pragma unroll
                    for (int n = 0; n < 2; ++n) { const pg8::f32x4 r = *(const pg8::f32x4*)(R + off + bj * 128 + n * 16);
                        *(pg8::f32x4*)(out + off + bj * 128 + n * 16) = r * ALPHA + acc[ai][bj][m][n]; } }
    }
};
struct EpiGlu {
    static constexpr bool PERM = true, AFTER_DRAIN = false;
    bf16_t* T;
    __device__ __forceinline__ void operator()(const pg8::f32x4 (&acc)[2][2][4][2], const pg8::Unit& u, int wr, int wc, int fr, int fq) const {
        const int row0 = u.pm * 256 + wr * 64 + fr, col0 = u.pn * 128 + wc * 32 + 8 * fq;
#pragma unroll
        for (int ai = 0; ai < 2; ++ai)
#pragma unroll
            for (int m = 0; m < 4; ++m) {
                float t[8];
#pragma unroll
                for (int n = 0; n < 2; ++n)
#pragma unroll
                    for (int j = 0; j < 4; ++j) { const float a = acc[ai][0][m][n][j], b = acc[ai][1][m][n][j]; t[n * 4 + j] = a * b / (1.0f + __expf(-a)); }
                u32x4 w; w.x = cvtpk(t[0], t[1]); w.y = cvtpk(t[2], t[3]); w.z = cvtpk(t[4], t[5]); w.w = cvtpk(t[6], t[7]);
                *(u32x4*)(T + (size_t)(row0 + ai * 128 + m * 16) * FFH + col0) = w; }
    }
};

__device__ __forceinline__ void tr_tile(const float* src, int ld, int sc, bf16_t* dst, int dstK, int n0, int k0, float* tile) {
    const int tid = otid(), lane = tid & 63, w = __builtin_amdgcn_readfirstlane(tid >> 6);
#pragma unroll
    for (int i = 0; i < 8; ++i) { const int k = w * 8 + i; tile[k * 65 + lane] = sc >= 0 ? src[(size_t)(k0 + k) * ld + sc] : 0.f; }
    __syncthreads();
    const int n = tid >> 3, k8 = (tid & 7) * 8;
    float v[8];
#pragma unroll
    for (int i = 0; i < 8; ++i) v[i] = tile[(k8 + i) * 65 + n];
    u32x4 w4; w4.x = cvtpk(v[0], v[1]); w4.y = cvtpk(v[2], v[3]); w4.z = cvtpk(v[4], v[5]); w4.w = cvtpk(v[6], v[7]);
    *(u32x4*)(dst + (size_t)(n0 + n) * dstK + k0 + k8) = w4;
    __syncthreads();
}
__device__ __forceinline__ int win_col(int n) {
    const int c = n >> 7, r = n & 127;
    if (c < 24) return n;
    if (c < 44) return 3088 + (c - 24) * 128 + r;
    if (c == 44) { if (r < 16) return 3072 + r; if (r < 40) return 5648 + (r - 16); }
    return -1;
}
__constant__ float ROPE_INV[16] = {1.000000000e+00f, 4.403665960e-01f, 1.939227432e-01f, 8.539710194e-02f, 3.760603070e-02f, 1.656043902e-02f, 7.292664610e-03f, 3.211445874e-03f,
                                   1.414213562e-03f, 6.227723788e-04f, 2.742481884e-04f, 1.207697351e-04f, 5.318296098e-05f, 2.341999971e-05f, 1.031338616e-05f, 4.541670478e-06f};

__device__ void transpose_w13(const Params& p, float* tile) {
    bf16_t* dst = (bf16_t*)(p.ws + WS_W13T);
    const int lane = otid() & 63;
    for (int it = blockIdx.x; it < 176 * 32; it += gridDim.x) { const int nt = it >> 5, kt = it & 31; const int n0 = nt * 64;
        const int pn = n0 >> 8, r = n0 & 255, which = r >> 7, j0 = pn * 128 + (r & 127);
        tr_tile(which ? p.ffn_w3 : p.ffn_w1, FFH, j0 + lane, dst, DM, n0, kt * 64, tile); }
}
__device__ void transpose_w2(const Params& p, float* tile) {
    bf16_t* dst = (bf16_t*)(p.ws + WS_W2T);
    const int lane = otid() & 63;
    for (int it = blockIdx.x; it < 32 * 88; it += gridDim.x) { const int nt = it / 88, kt = it % 88;
        tr_tile(p.ffn_w2, DM, nt * 64 + lane, dst, FFH, nt * 64, kt * 64, tile); }
}

__device__ void phase_convert(const Params& p, unsigned char* lds) {
    float* tile = (float*)lds;
    const int tid = otid(), lane = tid & 63;
    { const f32x4* xs = (const f32x4*)p.x; u32x2* xd = (u32x2*)(p.ws + WS_XB);
      for (size_t i = (size_t)blockIdx.x * 512 + tid; i < (size_t)NTOK * DM / 4; i += (size_t)gridDim.x * 512) { const f32x4 v = xs[i]; u32x2 w; w.x = cvtpk(v[0], v[1]); w.y = cvtpk(v[2], v[3]); xd[i] = w; } }
    { bf16_t* dst = (bf16_t*)(p.ws + WS_WINT);
      for (int it = blockIdx.x; it < 92 * 32; it += gridDim.x) { const int nt = it >> 5, kt = it & 31; tr_tile(p.w_in, INW, win_col(nt * 64 + lane), dst, DM, nt * 64, kt * 64, tile); } }
    { bf16_t* dst = (bf16_t*)(p.ws + WS_WOUTT);
      for (int it = blockIdx.x; it < 32 * 32; it += gridDim.x) { const int nt = it >> 5, kt = it & 31; tr_tile(p.w_out, DM, nt * 64 + lane, dst, DM, nt * 64, kt * 64, tile); } }
    for (int kv = 0; kv < 2; ++kv) {
        const float* w1 = kv ? p.cv_w1 : p.ck_w1; const float* w2 = kv ? p.cv_w2 : p.ck_w2;
        bf16_t* d1 = (bf16_t*)(p.ws + WS_CW1T) + (size_t)kv * 256 * 4096; bf16_t* d2 = (bf16_t*)(p.ws + WS_CW2T) + (size_t)kv * 128 * 256;
        for (int it = blockIdx.x; it < 4 * 64; it += gridDim.x) { const int nt = it >> 6, kt = it & 63; tr_tile(w1, 256, nt * 64 + lane, d1, 4096, nt * 64, kt * 64, tile); }
        for (int it = blockIdx.x; it < 2 * 4; it += gridDim.x) { const int nt = it >> 2, kt = it & 3; tr_tile(w2, 128, nt * 64 + lane, d2, 256, nt * 64, kt * 64, tile); }
    }
    for (int it = blockIdx.x; it < 32; it += gridDim.x) {
        const int kv = it >> 4, part = it & 15; const float* w1 = kv ? p.cv_w1 : p.ck_w1; const float* pos = kv ? p.cv_pos : p.ck_pos;
        const int j = tid & 255, half = tid >> 8; float s = 0.f;
        for (int i = 0; i < 128; ++i) { const int row = part * 256 + half * 128 + i; s += pos[row] * w1[(size_t)row * 256 + j]; }
        __syncthreads(); tile[tid] = s; __syncthreads();
        if (tid < 256) ((float*)(p.ws + WS_C1P))[(kv * 16 + part) * 256 + j] = tile[tid] + tile[tid + 256];
        __syncthreads();
    }
    { float* rc = (float*)(p.ws + WS_ROPE); float* rs = rc + 2048 * 16;
      for (int i = blockIdx.x * 512 + tid; i < 2048 * 16; i += gridDim.x * 512) { const int pos = i >> 4, k = i & 15;
          const float ang = (float)pos * ROPE_INV[k]; const double rev = (double)ang * 0.15915494309189535; const float fr = (float)(rev - rint(rev));
          rc[i] = __builtin_amdgcn_cosf(fr); rs[i] = __builtin_amdgcn_sinf(fr); } }
}

__device__ void phase_rope(const Params& p) {
    const float* rc = (const float*)(p.ws + WS_ROPE); const float* rs = rc + 2048 * 16;
    for (int idx = blockIdx.x * 512 + otid(); idx < 12 * NTOK; idx += gridDim.x * 512) {
        const int kind = idx / NTOK, tok = idx - kind * NTOK, pos = tok & (SEQ - 1);
        const bf16_t* src; bf16_t* dst;
        if (kind < 8) { src = uchunk(p, 24 + kind) + (size_t)tok * 128; dst = (bf16_t*)(p.ws + WS_QR) + ((size_t)kind * NTOK + tok) * 128; }
        else { const int c = kind < 10 ? 36 + (kind - 8) : 40 + (kind - 10); dst = uchunk(p, c) + (size_t)tok * 128; src = dst; }
        u32x4 a0 = ((const u32x4*)src)[0], a1 = ((const u32x4*)src)[1], b0 = ((const u32x4*)src)[2], b1 = ((const u32x4*)src)[3];
        unsigned xa[8] = {a0.x, a0.y, a0.z, a0.w, a1.x, a1.y, a1.z, a1.w}, xb[8] = {b0.x, b0.y, b0.z, b0.w, b1.x, b1.y, b1.z, b1.w};
        unsigned oa[8], ob[8];
#pragma unroll
        for (int i = 0; i < 8; ++i) {
            const float c0 = rc[pos * 16 + 2 * i], c1 = rc[pos * 16 + 2 * i + 1], s0 = rs[pos * 16 + 2 * i], s1 = rs[pos * 16 + 2 * i + 1];
            const float x10 = bflo(xa[i]), x11 = bfhi(xa[i]), x20 = bflo(xb[i]), x21 = bfhi(xb[i]);
            oa[i] = cvtpk(x10 * c0 - x20 * s0, x11 * c1 - x21 * s1);
            ob[i] = cvtpk(x20 * c0 + x10 * s0, x21 * c1 + x11 * s1);
        }
        ((u32x4*)dst)[0] = (u32x4){oa[0], oa[1], oa[2], oa[3]}; ((u32x4*)dst)[1] = (u32x4){oa[4], oa[5], oa[6], oa[7]};
        ((u32x4*)dst)[2] = (u32x4){ob[0], ob[1], ob[2], ob[3]}; ((u32x4*)dst)[3] = (u32x4){ob[4], ob[5], ob[6], ob[7]};
        if (kind < 8) {
#pragma unroll
            for (int i = 4; i < 16; ++i) ((u32x4*)dst)[i] = ((const u32x4*)src)[i];
        }
    }
}

__device__ __forceinline__ void gla_bc(const Params& p, int b, int h, int n, float* glr  , float* tot  , float (&bc)[16], float& blast) {
    const int tid = otid(), d = tid & 127, tq = tid >> 7;
    const size_t tok0 = (size_t)b * SEQ + n * 64;
    const bf16_t* u44 = uchunk(p, 44);
    __syncthreads();
    for (int i = tid; i < 1024; i += 512) glr[i] = bf2f(u44[(tok0 + (i >> 4)) * 128 + (i & 15)]);
    float w2[16];
#pragma unroll
    for (int r = 0; r < 16; ++r) w2[r] = p.gate_w2[r * 512 + h * 128 + d];
    const float bias = p.gate_b2[h * 128 + d];
    __syncthreads();
    float run = 0.f;
#pragma unroll
    for (int tt = 0; tt < 16; ++tt) { const int t = tq * 16 + tt; float z = bias;
#pragma unroll
        for (int r = 0; r < 16; ++r) z += glr[t * 16 + r] * w2[r];
        const float ls = fminf(z, 0.f) - log1pf(__expf(-fabsf(z)));
        run += ls * (1.0f / 16.0f); bc[tt] = run; }
    tot[tq * 128 + d] = run;
    __syncthreads();
    float off = 0.f, all = 0.f;
#pragma unroll
    for (int q = 0; q < 4; ++q) { const float v = tot[q * 128 + d]; all += v; if (q < tq) off += v; }
#pragma unroll
    for (int tt = 0; tt < 16; ++tt) bc[tt] += off;
    blast = all;
}
__device__ __forceinline__ void gla_stage_vT(const Params& p, int h, size_t tok0, bf16_t* vT) {
    const int tid = otid();
    for (int pc = tid; pc < 2048; pc += 512) { const int t = pc >> 5, e8 = (pc & 31) * 8;
        const bf16_t* src = uchunk(p, 8 + 2 * h + (e8 >> 7)) + (tok0 + t) * 128 + (e8 & 127);
        const u32x4 w = *(const u32x4*)src; const unsigned ww[4] = {w.x, w.y, w.z, w.w};
#pragma unroll
        for (int i = 0; i < 4; ++i) { vT[(e8 + 2 * i) * 72 + t] = (bf16_t)(ww[i] & 0xffffu); vT[(e8 + 2 * i + 1) * 72 + t] = (bf16_t)(ww[i] >> 16); } }
}
__device__ void gla_g1(const Params& p, int item, unsigned char* lds) {
    const int bh = item >> 5, n = item & 31, b = bh >> 2, h = bh & 3;
    const int tid = otid(), d = tid & 127, tq = tid >> 7, wid = __builtin_amdgcn_readfirstlane(tid >> 6), lane = tid & 63, r32 = lane & 31, hi = lane >> 5;
    float* glr = (float*)lds; float* tot = (float*)(lds + 4096);
    bf16_t* ksT = (bf16_t*)(lds + 8192); bf16_t* vT = (bf16_t*)(lds + 8192 + 128 * 72 * 2);
    const size_t tok0 = (size_t)b * SEQ + n * 64;
    float bc[16], blast; gla_bc(p, b, h, n, glr, tot, bc, blast);
    const bf16_t* kc = uchunk(p, 4 + h);
#pragma unroll
    for (int tt = 0; tt < 16; ++tt) { const int t = tq * 16 + tt; const float kv = bf2f(kc[(tok0 + t) * 128 + d]); ksT[d * 72 + t] = f2bf(kv * __expf(blast - bc[tt])); }
    if (tq == 0) ((float*)(p.ws + WS_DECAY))[(size_t)item * 128 + d] = __expf(blast);
    gla_stage_vT(p, h, tok0, vT);
    __syncthreads();
    f32x16 acc[4] = {};
#pragma unroll
    for (int ks = 0; ks < 4; ++ks) { const bf16x8 a = *(const bf16x8*)(vT + (wid * 32 + r32) * 72 + ks * 16 + hi * 8);
#pragma unroll
        for (int db = 0; db < 4; ++db) { const bf16x8 bb = *(const bf16x8*)(ksT + (db * 32 + r32) * 72 + ks * 16 + hi * 8); acc[db] = MFMA32(a, bb, acc[db]); } }
    bf16_t* ds = (bf16_t*)(p.ws + WS_DS) + (size_t)item * 256 * 128;
#pragma unroll
    for (int db = 0; db < 4; ++db)
#pragma unroll
        for (int r = 0; r < 16; ++r) ds[(wid * 32 + crow(r, hi)) * 128 + db * 32 + r32] = f2bf(acc[db][r]);
}
__device__ void phase_gla_scan(const Params& p) {
    bf16_t* ds = (bf16_t*)(p.ws + WS_DS); const float* dec = (const float*)(p.ws + WS_DECAY);
    for (int idx = blockIdx.x * 512 + otid(); idx < 16 * 256 * 16; idx += gridDim.x * 512) {
        const int bh = idx >> 12, e = (idx >> 4) & 255, d8 = (idx & 15) * 8;
        float st[8] = {0.f, 0.f, 0.f, 0.f, 0.f, 0.f, 0.f, 0.f};
#pragma unroll 4
        for (int n = 0; n < 32; ++n) {
            u32x4* ptr = (u32x4*)(ds + ((size_t)(bh * 32 + n) * 256 + e) * 128 + d8);
            const u32x4 w = *ptr; const f32x4 dc0 = *(const f32x4*)(dec + (size_t)(bh * 32 + n) * 128 + d8), dc1 = *(const f32x4*)(dec + (size_t)(bh * 32 + n) * 128 + d8 + 4);
            u32x4 o; o.x = cvtpk(st[0], st[1]); o.y = cvtpk(st[2], st[3]); o.z = cvtpk(st[4], st[5]); o.w = cvtpk(st[6], st[7]);
            *ptr = o;
            st[0] = dc0[0] * st[0] + bflo(w.x); st[1] = dc0[1] * st[1] + bfhi(w.x); st[2] = dc0[2] * st[2] + bflo(w.y); st[3] = dc0[3] * st[3] + bfhi(w.y);
            st[4] = dc1[0] * st[4] + bflo(w.z); st[5] = dc1[1] * st[5] + bfhi(w.z); st[6] = dc1[2] * st[6] + bflo(w.w); st[7] = dc1[3] * st[7] + bfhi(w.w);
        }
    }
}
__device__ void gla_g3(const Params& p, int item, unsigned char* lds) {
    const int bh = item >> 5, n = item & 31, b = bh >> 2, h = bh & 3;
    const int tid = otid(), d = tid & 127, tq = tid >> 7, wid = __builtin_amdgcn_readfirstlane(tid >> 6), lane = tid & 63, r32 = lane & 31, hi = lane >> 5;
    float* glr = (float*)lds; float* tot = (float*)(lds + 4096);
    bf16_t* qd = (bf16_t*)(lds + 8192); bf16_t* ki = (bf16_t*)(lds + 25600); bf16_t* vT = (bf16_t*)(lds + 43008); bf16_t* at = (bf16_t*)(lds + 79872);
    float* ol = (float*)(lds + 8192);
    const size_t tok0 = (size_t)b * SEQ + n * 64;
    float bc[16], blast; gla_bc(p, b, h, n, glr, tot, bc, blast);
    const bf16_t* qc = uchunk(p, h); const bf16_t* kc = uchunk(p, 4 + h);
#pragma unroll
    for (int tt = 0; tt < 16; ++tt) { const int t = tq * 16 + tt; const float e = __expf(bc[tt]);
        qd[t * 136 + d] = f2bf(bf2f(qc[(tok0 + t) * 128 + d]) * 0.08838834764831845f * e);
        ki[t * 136 + d] = f2bf(bf2f(kc[(tok0 + t) * 128 + d]) / e); }
    gla_stage_vT(p, h, tok0, vT);
    __syncthreads();
    const int ib = wid & 1, eb = (wid >> 1) * 2;
    f32x16 acc[2] = {};
    { const bf16_t* sp = (const bf16_t*)(p.ws + WS_DS) + (size_t)item * 256 * 128;
#pragma unroll
      for (int ks = 0; ks < 8; ++ks) { const bf16x8 a = *(const bf16x8*)(qd + (ib * 32 + r32) * 136 + ks * 16 + hi * 8);
#pragma unroll
          for (int x = 0; x < 2; ++x) { const bf16x8 bb = *(const bf16x8*)(sp + ((eb + x) * 32 + r32) * 128 + ks * 16 + hi * 8); acc[x] = MFMA32(a, bb, acc[x]); } } }
    if (wid < 4) { const int jb = wid >> 1; f32x16 s = {};
#pragma unroll
        for (int ks = 0; ks < 8; ++ks) { const bf16x8 a = *(const bf16x8*)(qd + (ib * 32 + r32) * 136 + ks * 16 + hi * 8); const bf16x8 bb = *(const bf16x8*)(ki + (jb * 32 + r32) * 136 + ks * 16 + hi * 8); s = MFMA32(a, bb, s); }
#pragma unroll
        for (int r = 0; r < 16; ++r) { const int i = ib * 32 + crow(r, hi), j = jb * 32 + r32; at[i * 72 + j] = f2bf(j <= i ? s[r] : 0.f); } }
    __syncthreads();
#pragma unroll
    for (int ks = 0; ks < 4; ++ks) { const bf16x8 a = *(const bf16x8*)(at + (ib * 32 + r32) * 72 + ks * 16 + hi * 8);
#pragma unroll
        for (int x = 0; x < 2; ++x) { const bf16x8 bb = *(const bf16x8*)(vT + ((eb + x) * 32 + r32) * 72 + ks * 16 + hi * 8); acc[x] = MFMA32(a, bb, acc[x]); } }
    __syncthreads();
#pragma unroll
    for (int x = 0; x < 2; ++x)
#pragma unroll
        for (int r = 0; r < 16; ++r) ol[(ib * 32 + crow(r, hi)) * 256 + (eb + x) * 32 + r32] = acc[x][r];
    __syncthreads();
    { const int row = tid >> 3, seg = tid & 7; const float* orow = ol + row * 256 + seg * 32; float ss = 0.f;
#pragma unroll
      for (int i = 0; i < 32; ++i) ss += orow[i] * orow[i];
      ss += __shfl_xor(ss, 1); ss += __shfl_xor(ss, 2); ss += __shfl_xor(ss, 4);
      const float rstd = rsqrtf(ss * (1.0f / 256.0f) + LN_EPS);
      const int e0 = seg * 32; const bf16_t* go = uchunk(p, 16 + 2 * h + (e0 >> 7)) + (tok0 + row) * 128 + (e0 & 127);
      bf16_t* dst = (bf16_t*)(p.ws + WS_A) + (tok0 + row) * DM + h * 256 + e0;
#pragma unroll
      for (int c = 0; c < 4; ++c) { const u32x4 g = ((const u32x4*)go)[c]; const unsigned gw[4] = {g.x, g.y, g.z, g.w}; unsigned ow[4];
#pragma unroll
          for (int i = 0; i < 4; ++i) { const int e = c * 8 + 2 * i; const float g0 = bflo(gw[i]), g1 = bfhi(gw[i]);
              const float v0 = orow[e] * rstd * p.norm_w[e0 + e] * g0 / (1.0f + __expf(-g0)), v1 = orow[e + 1] * rstd * p.norm_w[e0 + e + 1] * g1 / (1.0f + __expf(-g1));
              ow[i] = cvtpk(v0, v1); }
          ((u32x4*)dst)[c] = (u32x4){ow[0], ow[1], ow[2], ow[3]}; } }
    __syncthreads();
}

__device__ void compress_item(const Params& p, int item, unsigned char* lds) {
    const int kv = item >> 5, g = (item >> 4) & 1, rt = item & 15;
    const int tid = otid(), wid = __builtin_amdgcn_readfirstlane(tid >> 6), lane = tid & 63, r32 = lane & 31, hi = lane >> 5;
    const int ksl = wid >> 1, nh = wid & 1;
    const bf16_t* A = uchunk(p, 32 + 2 * kv + g) + (size_t)(rt * 32 + r32) * 2048 + ksl * 1024 + hi * 8;
    const bf16_t* W = (const bf16_t*)(p.ws + WS_CW1T) + (size_t)kv * 256 * 4096 + (size_t)(nh * 128 + r32) * 4096 + ksl * 1024 + hi * 8;
    f32x16 acc[4] = {};
#pragma unroll 2
    for (int ks = 0; ks < 64; ++ks) { const bf16x8 a = *(const bf16x8*)(A + ks * 16);
#pragma unroll
        for (int nb = 0; nb < 4; ++nb) { const bf16x8 bb = *(const bf16x8*)(W + (size_t)nb * 32 * 4096 + ks * 16); acc[nb] = MFMA32(a, bb, acc[nb]); } }
    float* hid = (float*)lds;
    bf16_t* hb = (bf16_t*)(lds + 32768);
    __syncthreads();
    for (int s = 0; s < 4; ++s) {
        if (ksl == s) {
#pragma unroll
            for (int nb = 0; nb < 4; ++nb)
#pragma unroll
                for (int r = 0; r < 16; ++r) { float* q = hid + crow(r, hi) * 256 + nh * 128 + nb * 32 + r32; *q = (s == 0 ? 0.f : *q) + acc[nb][r]; } }
        __syncthreads();
    }
    { const float* c1p = (const float*)(p.ws + WS_C1P) + kv * 16 * 256;
      for (int i = tid; i < 32 * 256; i += 512) { const int j = i & 255; float v = hid[i];
#pragma unroll
          for (int q = 0; q < 16; ++q) v += c1p[q * 256 + j];
          const float u = 0.7978845608028654f * (v + 0.044715f * v * v * v); const float th = 1.0f - 2.0f / (__expf(2.0f * u) + 1.0f);
          hb[(i >> 8) * 264 + j] = f2bf(0.5f * v * (1.0f + th)); } }
    __syncthreads();
    if (wid < 4) { const bf16_t* W2 = (const bf16_t*)(p.ws + WS_CW2T) + (size_t)kv * 128 * 256 + (size_t)(wid * 32 + r32) * 256 + hi * 8; f32x16 o = {};
#pragma unroll
        for (int ks = 0; ks < 16; ++ks) { const bf16x8 a = *(const bf16x8*)(hb + r32 * 264 + ks * 16 + hi * 8); const bf16x8 bb = *(const bf16x8*)(W2 + ks * 16); o = MFMA32(a, bb, o); }
        bf16_t* dst = (bf16_t*)(p.ws + WS_KCMP) + (size_t)kv * 4 * 2 * 128 * 128;
#pragma unroll
        for (int r = 0; r < 16; ++r) { const int m = rt * 32 + crow(r, hi), bb_ = m >> 7, nn = m & 127; dst[((size_t)(bb_ * 2 + g) * 128 + nn) * 128 + wid * 32 + r32] = nn == 127 ? (bf16_t)0 : f2bf(o[r]); } }
    __syncthreads();
}

constexpr int SHM_K = 16384, SHM_V = 16384;
constexpr float SCALE = 0.08838834764831845f;
constexpr float THR = 8.f;
#define KSWZ(row, colB) ((row) * 256 + ((colB) ^ (((row) & 7) << 4)))
#define SBAR() __builtin_amdgcn_sched_barrier(0)
__device__ __forceinline__ int v_st(int k, int c) { const int kk = (k & ~0xC) | ((k & 4) << 1) | ((k & 8) >> 1); return ((kk >> 3) * 4 + (c >> 5)) * 512 + ((kk & 7) * 32 + (c & 31)) * 2; }
__device__ __forceinline__ int v_rd_base(int lane) { return ((lane & 3) << 3) | (((lane >> 2) & 3) << 6) | (((lane >> 4) & 1) << 5) | (((lane >> 5) & 1) << 8); }
constexpr int v_rd_off(int d0, int ks, int half) { return d0 * 512 + ks * 4096 + half * 2048; }
__device__ __forceinline__ void mask_tile(f32x16& p0, f32x16& p1, int dq, unsigned W) {
    const float NEG = -__builtin_inff();
#pragma unroll
    for (int r = 0; r < 16; ++r) { const int c = (r & 3) + 8 * (r >> 2);
        if ((unsigned)(dq - c) >= W) p0[r] = NEG;
        if ((unsigned)(dq - c - 32) >= W) p1[r] = NEG; }
}
__device__ __forceinline__ void partialSM(f32x16& p0, f32x16& p1, float& m_reg, float& mn, float& alpha) {
    float pmax = p0[0];
#pragma unroll
    for (int r = 1; r < 16; ++r) pmax = fmaxf(pmax, p0[r]);
#pragma unroll
    for (int r = 0; r < 16; ++r) pmax = fmaxf(pmax, p1[r]);
    { auto rr = __builtin_amdgcn_permlane32_swap(__float_as_uint(pmax), __float_as_uint(pmax), false, false);
      pmax = fmaxf(__uint_as_float(rr[0]), __uint_as_float(rr[1])); }
    constexpr float C2 = 1.4426950408889634f * SCALE;
    if (__builtin_expect(__all((pmax - m_reg) * SCALE <= THR), 1)) { mn = m_reg; alpha = 1.f; }
    else { mn = fmaxf(m_reg, pmax); alpha = __builtin_amdgcn_exp2f((m_reg - mn) * C2); m_reg = mn; }
    const float mnL = -mn * C2;
#pragma unroll
    for (int r = 0; r < 16; ++r) p0[r] = fmaf(p0[r], C2, mnL);
#pragma unroll
    for (int r = 0; r < 16; ++r) p1[r] = fmaf(p1[r], C2, mnL);
#pragma unroll
    for (int r = 0; r < 16; ++r) p0[r] = __builtin_amdgcn_exp2f(p0[r]);
}
#define PK4(P, B_, OUT) do { unsigned a0 = cvtpk(P[B_+0], P[B_+1]), a1 = cvtpk(P[B_+2], P[B_+3]);                          \
        unsigned b0 = cvtpk(P[B_+4], P[B_+5]), b1 = cvtpk(P[B_+6], P[B_+7]);                                             \
        auto r0 = __builtin_amdgcn_permlane32_swap(a0, b0, false, false); auto r1 = __builtin_amdgcn_permlane32_swap(a1, b1, false, false); \
        u32x4 w = {r0[0], r1[0], r0[1], r1[1]}; OUT = *reinterpret_cast<bf16x8*>(&w); } while (0)
__device__ __forceinline__ void pack_p(const f32x16& p0, const f32x16& p1, bf16x8& pa0, bf16x8& pa1, bf16x8& pa2, bf16x8& pa3) {
    PK4(p0, 0, pa0); PK4(p0, 8, pa1); PK4(p1, 0, pa2); PK4(p1, 8, pa3);
}
__device__ __forceinline__ void finishSM(f32x16& p0, f32x16& p1, float alpha, float& l_reg, bf16x8& pa0, bf16x8& pa1, bf16x8& pa2, bf16x8& pa3) {
#pragma unroll
    for (int r = 0; r < 16; ++r) p1[r] = __builtin_amdgcn_exp2f(p1[r]);
    float ps = 0;
#pragma unroll
    for (int r = 0; r < 16; ++r) ps += p0[r];
#pragma unroll
    for (int r = 0; r < 16; ++r) ps += p1[r];
    { auto rr = __builtin_amdgcn_permlane32_swap(__float_as_uint(ps), __float_as_uint(ps), false, false);
      ps = __uint_as_float(rr[0]) + __uint_as_float(rr[1]); }
    l_reg = l_reg * alpha + ps;
    pack_p(p0, p1, pa0, pa1, pa2, pa3);
}
template <int KB>
__device__ __forceinline__ void qkt(f32x16& p0, f32x16& p1, const char* K_lds, int r32, int hi, const bf16x8* qr) {
    p0 = f32x16{}; p1 = f32x16{};
    const char* kb[4];
#pragma unroll
    for (int dd = 0; dd < 4; ++dd) kb[dd] = K_lds + KB * SHM_K + KSWZ(r32, (dd * 16 + hi * 8) * 2);
#pragma unroll
    for (int d0 = 0; d0 < 8; ++d0) { const char* a = kb[d0 & 3] + (d0 >> 2) * 128;
        bf16x8 b0 = *reinterpret_cast<const bf16x8*>(a);
        bf16x8 b1 = *reinterpret_cast<const bf16x8*>(a + 32 * 256);
        p0 = MFMA32(b0, qr[d0], p0);
        p1 = MFMA32(b1, qr[d0], p1); }
}
template <int VB>
__device__ __forceinline__ void pv_tile(f32x16* o, int vb0, bf16x8 pa0, bf16x8 pa1, bf16x8 pa2, bf16x8 pa3) {
#define TRRD(dst, off) asm volatile("ds_read_b64_tr_b16 %0, %1 offset:%2" : "=&v"(dst) : "v"(vb0), "i"(off) : "memory")
#define PV_D0(d0) do { s16x4 l0, l1, l2, l3, h0, h1, h2, h3; constexpr int b_ = VB * SHM_V + v_rd_off(d0, 0, 0); \
        TRRD(l0, b_); TRRD(h0, b_ + 2048); TRRD(l1, b_ + 4096); TRRD(h1, b_ + 6144); TRRD(l2, b_ + 8192); TRRD(h2, b_ + 10240); TRRD(l3, b_ + 12288); TRRD(h3, b_ + 14336); \
        asm volatile("s_waitcnt lgkmcnt(0)" ::: "memory"); SBAR(); \
        o[d0] = MFMA32(pa0, ((bf16x8){l0[0], l0[1], l0[2], l0[3], h0[0], h0[1], h0[2], h0[3]}), o[d0]);   \
        o[d0] = MFMA32(pa1, ((bf16x8){l1[0], l1[1], l1[2], l1[3], h1[0], h1[1], h1[2], h1[3]}), o[d0]);   \
        o[d0] = MFMA32(pa2, ((bf16x8){l2[0], l2[1], l2[2], l2[3], h2[0], h2[1], h2[2], h2[3]}), o[d0]);   \
        o[d0] = MFMA32(pa3, ((bf16x8){l3[0], l3[1], l3[2], l3[3], h3[0], h3[1], h3[2], h3[3]}), o[d0]); } while (0)
    PV_D0(0); PV_D0(1); PV_D0(2); PV_D0(3);
#undef PV_D0
#undef TRRD
}
__device__ __forceinline__ void stage_kv(const bf16_t* Kg, const bf16_t* Vg, char* K_lds, char* V_lds, int bf) {
    const int tid = otid(), sr = tid >> 4, sc = (tid & 15) * 8;
    const bf16x8 k0 = *(const bf16x8*)(Kg + (size_t)sr * 128 + sc), k1 = *(const bf16x8*)(Kg + (size_t)(32 + sr) * 128 + sc);
    const bf16x8 v0 = *(const bf16x8*)(Vg + (size_t)sr * 128 + sc), v1 = *(const bf16x8*)(Vg + (size_t)(32 + sr) * 128 + sc);
    *(bf16x8*)(K_lds + bf * SHM_K + KSWZ(sr, sc * 2)) = k0; *(bf16x8*)(K_lds + bf * SHM_K + KSWZ(sr, sc * 2) + 32 * 256) = k1;
    *(bf16x8*)(V_lds + bf * SHM_V + v_st(sr, sc)) = v0; *(bf16x8*)(V_lds + bf * SHM_V + v_st(32 + sr, sc)) = v1;
}

__device__ void cmp_item(const Params& p, int item, unsigned char* ldsu) {
    char* lds = (char*)ldsu;
    const int b = item >> 6, g = (item >> 5) & 1, tt = item & 31;
    const int tid = otid(), wid = __builtin_amdgcn_readfirstlane(tid >> 6), lane = tid & 63, r32 = lane & 31, hi = lane >> 5;
    const int hh = wid & 3, sb = wid >> 2, head = g * 4 + hh, t = tt * 64 + sb * 32 + r32;
    const size_t tok = (size_t)b * SEQ + t;
    char* V_lds = lds; char* K_lds = lds + 2 * SHM_V;
    float* wsf = (float*)(lds + 2 * SHM_V + 2 * SHM_K) + wid * 64;
    float* impw = (float*)(lds + 67584); float* imps = (float*)(lds + 67584 + 32768);
    const bf16_t* kc = (const bf16_t*)(p.ws + WS_KCMP) + (size_t)((0 * 4 + b) * 2 + g) * 128 * 128;
    const bf16_t* vc = (const bf16_t*)(p.ws + WS_KCMP) + (size_t)((1 * 4 + b) * 2 + g) * 128 * 128;
    __syncthreads();
    stage_kv(kc, vc, K_lds, V_lds, 0); stage_kv(kc + 64 * 128, vc + 64 * 128, K_lds, V_lds, 1);
    bf16x8 qr[8];
    { const bf16_t* Q = uchunk(p, 24 + head) + tok * 128;
#pragma unroll
      for (int d0 = 0; d0 < 8; ++d0) qr[d0] = *(const bf16x8*)(Q + d0 * 16 + hi * 8); }
    __syncthreads();
    const int nmax = (t - 31) >> 4; const float NEG = -__builtin_inff();
    constexpr float C2 = 1.4426950408889634f * SCALE;
    float* invw = (float*)(lds + 67584 + 32768 + 8192);
    float mx = NEG;
    { f32x16 s0, s1;
      qkt<0>(s0, s1, K_lds, r32, hi, qr);
#pragma unroll
      for (int r = 0; r < 16; ++r) { const int key = (r & 3) + 8 * (r >> 2) + 4 * hi; mx = fmaxf(mx, key <= nmax ? s0[r] : NEG); mx = fmaxf(mx, key + 32 <= nmax ? s1[r] : NEG); }
      SBAR(); qkt<1>(s0, s1, K_lds, r32, hi, qr);
#pragma unroll
      for (int r = 0; r < 16; ++r) { const int key = 64 + (r & 3) + 8 * (r >> 2) + 4 * hi; mx = fmaxf(mx, key <= nmax ? s0[r] : NEG); mx = fmaxf(mx, key + 32 <= nmax ? s1[r] : NEG); } }
    { auto rr = __builtin_amdgcn_permlane32_swap(__float_as_uint(mx), __float_as_uint(mx), false, false); mx = fmaxf(__uint_as_float(rr[0]), __uint_as_float(rr[1])); }
    const float mref = (mx == NEG) ? 0.f : mx, mnL = -mref * C2;
    float sum = 0.f, plPrev = 0.f;
    f32x16 o[4] = {};
    const int vb0 = (int)(uintptr_t)V_lds + v_rd_base(lane);
#define IMP_SRC(P, base) _Pragma("unroll") for (int q = 0; q < 4; ++q) { const float Gq = (P[4 * q] + P[4 * q + 1]) + (P[4 * q + 2] + P[4 * q + 3]); const float pl = __shfl_xor(P[4 * q + 3], 32); \
          impw[(wid * 32 + r32) * 32 + 2 * ((base) + q) + hi] = Gq + (hi ? pl : plPrev); plPrev = pl; }
#define CMP_TILE(TB) do { f32x16 p0, p1; bf16x8 pa0, pa1, pa2, pa3; qkt<TB>(p0, p1, K_lds, r32, hi, qr); \
      _Pragma("unroll") for (int r = 0; r < 16; ++r) { const int key = TB * 64 + (r & 3) + 8 * (r >> 2) + 4 * hi; \
          p0[r] = key <= nmax ? __builtin_amdgcn_exp2f(fmaf(p0[r], C2, mnL)) : 0.f; p1[r] = key + 32 <= nmax ? __builtin_amdgcn_exp2f(fmaf(p1[r], C2, mnL)) : 0.f; sum += p0[r] + p1[r]; } \
      SBAR(); IMP_SRC(p0, TB * 8) IMP_SRC(p1, TB * 8 + 4) SBAR(); \
      pack_p(p0, p1, pa0, pa1, pa2, pa3); pv_tile<TB>(o, vb0, pa0, pa1, pa2, pa3); } while (0)
    SBAR(); CMP_TILE(0); SBAR(); CMP_TILE(1); SBAR();
#undef CMP_TILE
#undef IMP_SRC
    { auto rr = __builtin_amdgcn_permlane32_swap(__float_as_uint(sum), __float_as_uint(sum), false, false); sum = __uint_as_float(rr[0]) + __uint_as_float(rr[1]); }
    const float inv = sum > 0.f ? 1.0f / sum : 0.f;
    if (hi == 0) { wsf[r32] = inv * sigmoidf_(bf2f(uchunk(p, 44)[tok * 128 + 16 + head * 3 + 0])); invw[wid * 32 + r32] = inv; }

    asm volatile("s_waitcnt lgkmcnt(0)" ::: "memory");
    { bf16_t* O = (bf16_t*)(p.ws + WS_OP) + ((size_t)b * SEQ + tt * 64 + sb * 32) * 1024 + head * 128;
#pragma unroll
      for (int r = 0; r < 16; ++r) { const int orow = crow(r, hi); const float gt = wsf[orow];
#pragma unroll
          for (int d0 = 0; d0 < 4; ++d0) O[(size_t)orow * 1024 + d0 * 32 + r32] = f2bf(o[d0][r] * gt); } }
    __syncthreads();
    { const int tokl = tid >> 3, jq = tid & 7, tpos = tt * 64 + tokl, cur = tpos >> 6, sbt = tokl >> 5, rr_ = tokl & 31;
#pragma unroll
      for (int jj = 0; jj < 4; ++jj) { const int j = jq * 4 + jj; float v = 0.f;
#pragma unroll
          for (int h4 = 0; h4 < 4; ++h4) v += impw[((sbt * 4 + h4) * 32 + rr_) * 32 + j] * invw[(sbt * 4 + h4) * 32 + rr_];
          if (j > cur) v = -1e4f;
          if (j == 0 || j == cur || j == cur - 1) v = 1e4f;
          imps[tokl * 32 + j] = v; }
      __syncthreads();
      float vi[32];
#pragma unroll
      for (int i = 0; i < 32; ++i) vi[i] = imps[tokl * 32 + i];
      unsigned word = 0;
#pragma unroll
      for (int jj = 0; jj < 4; ++jj) { const int j = jq * 4 + jj; const float vj = imps[tokl * 32 + j]; int cnt = 0;
#pragma unroll
          for (int i = 0; i < 32; ++i) cnt += (vi[i] > vj || (vi[i] == vj && i < j)) ? 1 : 0;
          if (cnt < 16) word |= 1u << j; }
      word |= __shfl_xor(word, 1); word |= __shfl_xor(word, 2); word |= __shfl_xor(word, 4);
      if (jq == 0) ((unsigned*)(p.ws + WS_MASK))[(size_t)(b * 2 + g) * SEQ + tpos] = word; }
    __syncthreads();
}

template <int MODE>
__device__ void attn_block(const Params& p, int b, int head, int qb, unsigned char* ldsu) {
    char* lds = (char*)ldsu;
    const int tid = otid(), wid = __builtin_amdgcn_readfirstlane(tid >> 6), lane = tid & 63, r32 = lane & 31, hi = lane >> 5;
    const int g = head >> 2, P0 = qb * 256, qlo = P0 + wid * 32, qpos = qlo + r32, qm = qpos - 4 * hi;
    const size_t tokb = (size_t)b * SEQ;
    char* V_lds = lds; char* K_lds = lds + 2 * SHM_V;
    float* wsf = (float*)(lds + 2 * SHM_V + 2 * SHM_K) + wid * 64; float* li_l = wsf; float* al_l = wsf + 32;
    const bf16_t* K = uchunk(p, (MODE ? 36 : 40) + g) + tokb * 128; const bf16_t* V = uchunk(p, (MODE ? 38 : 42) + g) + tokb * 128;
    bf16x8 qr[8];
    { const bf16_t* Q = (const bf16_t*)(p.ws + WS_QR) + ((size_t)head * NTOK + tokb + qpos) * 128;
#pragma unroll
      for (int d0 = 0; d0 < 8; ++d0) qr[d0] = *(const bf16x8*)(Q + d0 * 16 + hi * 8); }
    const unsigned msk = MODE ? ((const unsigned*)(p.ws + WS_MASK))[(size_t)(b * 2 + g) * SEQ + qpos] : 0u;
    const int j_lo = MODE ? 0 : ((P0 - 511 > 0 ? P0 - 511 : 0) >> 6), j_hi = qb * 4 + 4;
    float m_reg = -1e30f, l_reg = 0.f; f32x16 o[4] = {};
    const int vb0 = (int)(uintptr_t)V_lds + v_rd_base(lane);
    for (int j = j_lo; j < j_hi; ++j) {
        const int kb = j * 64;
        __syncthreads();
        stage_kv(K + (size_t)kb * 128, V + (size_t)kb * 128, K_lds, V_lds, 0);
        __syncthreads();
        const bool act = MODE ? (kb <= qlo + 31) : (kb <= qlo + 31 && kb + 63 >= qlo - 511);
        if (!act) continue;
        if (MODE) { if (!__any((int)((msk >> j) & 1u))) continue; }
        f32x16 p0, p1; float mn, alpha; bf16x8 pa0, pa1, pa2, pa3;
        qkt<0>(p0, p1, K_lds, r32, hi, qr);
        if (MODE == 0) { if (kb + 63 > qlo || kb <= qlo + 31 - 512) mask_tile(p0, p1, qm - kb, 512u); }
        else { if (kb + 63 > qlo) mask_tile(p0, p1, qm - kb, 0x7fffffffu);
               if (!((msk >> j) & 1u)) { const float NEG = -__builtin_inff();
#pragma unroll
                   for (int r = 0; r < 16; ++r) { p0[r] = NEG; p1[r] = NEG; } } }
        partialSM(p0, p1, m_reg, mn, alpha);
        if (__any(alpha < 1.f)) { if (hi == 0) al_l[r32] = alpha; asm volatile("s_waitcnt lgkmcnt(0)" ::: "memory");
#pragma unroll
            for (int d_ = 0; d_ < 4; ++d_)
#pragma unroll
                for (int r = 0; r < 16; ++r) o[d_][r] *= al_l[crow(r, hi)]; }
        finishSM(p0, p1, alpha, l_reg, pa0, pa1, pa2, pa3);
        pv_tile<0>(o, vb0, pa0, pa1, pa2, pa3);
    }
    if (hi == 0) { li_l[r32] = l_reg; al_l[r32] = sigmoidf_(bf2f(uchunk(p, 44)[(tokb + qpos) * 128 + 16 + head * 3 + (MODE ? 1 : 2)])); }
    asm volatile("s_waitcnt lgkmcnt(0)" ::: "memory");
    { bf16_t* O = (bf16_t*)(p.ws + WS_OP) + (size_t)(MODE ? 1 : 2) * NTOK * 1024 + (tokb + qlo) * 1024 + head * 128;
#pragma unroll
      for (int r = 0; r < 16; ++r) { const int orow = crow(r, hi); const float sc = al_l[orow] / li_l[orow];
#pragma unroll
          for (int d0 = 0; d0 < 4; ++d0) O[(size_t)orow * 1024 + d0 * 32 + r32] = f2bf(o[d0][r] * sc); } }
    __syncthreads();
}

__device__ void phase_combine(const Params& p) {
    const u32x4* o0 = (const u32x4*)(p.ws + WS_OP); const u32x4* o1 = o0 + (size_t)NTOK * 1024 / 8; const u32x4* o2 = o1 + (size_t)NTOK * 1024 / 8;
    bf16_t* A = (bf16_t*)(p.ws + WS_A);
    for (size_t i = (size_t)blockIdx.x * 512 + otid(); i < (size_t)NTOK * 128; i += (size_t)gridDim.x * 512) {
        const size_t tok = i >> 7; const int c8 = (int)(i & 127) * 8;
        const u32x4 a = o0[i], b = o1[i], c = o2[i]; u32x4 w;
        w.x = cvtpk(bflo(a.x) + bflo(b.x) + bflo(c.x), bfhi(a.x) + bfhi(b.x) + bfhi(c.x));
        w.y = cvtpk(bflo(a.y) + bflo(b.y) + bflo(c.y), bfhi(a.y) + bfhi(b.y) + bfhi(c.y));
        w.z = cvtpk(bflo(a.z) + bflo(b.z) + bflo(c.z), bfhi(a.z) + bfhi(b.z) + bfhi(c.z));
        w.w = cvtpk(bflo(a.w) + bflo(b.w) + bflo(c.w), bfhi(a.w) + bfhi(b.w) + bfhi(c.w));
        *(u32x4*)(A + tok * DM + 1024 + c8) = w;
    }
}

template <bool WRITE_BF>
__device__ void phase_ln(const Params& p, const float* gam, const float* bet) {
    const int wid = __builtin_amdgcn_readfirstlane(otid() >> 6), lane = otid() & 63;
    for (int row = blockIdx.x * 8 + wid; row < NTOK; row += gridDim.x * 8) {
        float* rp = p.out + (size_t)row * DM;
        f32x4 v[8]; float s = 0.f;
#pragma unroll
        for (int i = 0; i < 8; ++i) { v[i] = *(const f32x4*)(rp + (i * 64 + lane) * 4); s += (v[i][0] + v[i][1]) + (v[i][2] + v[i][3]); }
#pragma unroll
        for (int o = 32; o >= 1; o >>= 1) s += __shfl_xor(s, o);
        const float mean = s * (1.0f / DM); float q = 0.f;
#pragma unroll
        for (int i = 0; i < 8; ++i) { const f32x4 d = v[i] - mean; q += (d[0] * d[0] + d[1] * d[1]) + (d[2] * d[2] + d[3] * d[3]); }
#pragma unroll
        for (int o = 32; o >= 1; o >>= 1) q += __shfl_xor(q, o);
        const float rstd = rsqrtf(q * (1.0f / DM) + LN_EPS);
#pragma unroll
        for (int i = 0; i < 8; ++i) { const int c = (i * 64 + lane) * 4; const f32x4 gg = *(const f32x4*)(gam + c), bb = *(const f32x4*)(bet + c);
            const f32x4 y = (v[i] - mean) * rstd * gg + bb; *(f32x4*)(rp + c) = y;
            if (WRITE_BF) { u32x2 w; w.x = cvtpk(y[0], y[1]); w.y = cvtpk(y[2], y[3]); *(u32x2*)((bf16_t*)(p.ws + WS_HB) + (size_t)row * DM + c) = w; } }
    }
}

template <class Epi>
__device__ __forceinline__ void run_gemm(unsigned char* shm, const bf16_t* A, const bf16_t* Bt, int M, int N, int K, const Epi& E) {
    pg8::StaticOrder S; S.init(M, N, (int)gridDim.x, (int)blockIdx.x);
    pg8::Gemm g{A, Bt, M, N, K};
    pg8::gemm_phase<Epi, pg8::StaticOrder, false>((PG8_LAS unsigned char*)shm, g, S, E, nullptr);
    __syncthreads();
}
__device__ void phase_p2(const Params& p, unsigned char* shm) {
    phase_rope(p);
    const int G = gridDim.x, w = blockIdx.x;
    if (G > 64) { if (w < 64) compress_item(p, w, shm); else for (int i = w - 64; i < 512; i += G - 64) gla_g1(p, i, shm); }
    else { for (int i = w; i < 64; i += G) compress_item(p, i, shm); for (int i = w; i < 512; i += G) gla_g1(p, i, shm); }
}
__device__ __forceinline__ bool p4_decode(int i, int& mode, int& qb, int& bh) {
    bh = i & 31;
    if (i < 192) { mode = 1; qb = 7 - (i >> 5); }
    else if (i < 384) { mode = 0; qb = 2 + ((i - 192) >> 5); }
    else if (i < 416) { mode = 1; qb = 1; } else if (i < 448) { mode = 0; qb = 1; } else if (i < 480) { mode = 1; qb = 0; } else { mode = 0; qb = 0; }
    return i < 512;
}
template <int SEL>
__device__ __forceinline__ void p4_loop(const Params& p, unsigned char* shm) {
    const int G = gridDim.x;
    for (int k = 0; k * G < 1024; ++k) {
        const int i = k * G + ((k & 1) ? G - 1 - (int)blockIdx.x : (int)blockIdx.x);
        if (i >= 1024) continue;
        if (SEL == 2) { if (i >= 512) gla_g3(p, i - 512, shm); continue; }
        int mode, qb, bh; if (!p4_decode(i, mode, qb, bh)) continue;
        if (mode != SEL) continue;
        attn_block<SEL>(p, bh >> 3, bh & 7, qb, shm);
    }
}
__device__ void phase_p4(const Params& p, unsigned char* shm) {
    p4_loop<1>(p, shm); p4_loop<0>(p, shm); p4_loop<2>(p, shm);
}
constexpr int NPHASE = 11;
#ifndef SUBSEL
#define SUBSEL 0
#endif
template <int PH>
__device__ __forceinline__ void run_phase(const Params& p, unsigned char* shm) {
    if constexpr (PH == 0) phase_convert(p, shm);
    if constexpr (PH == 1) run_gemm(shm, (const bf16_t*)(p.ws + WS_XB), (const bf16_t*)(p.ws + WS_WINT), NTOK, UW, DM, EpiU{(bf16_t*)(p.ws + WS_U)});
    if constexpr (PH == 2) phase_p2(p, shm);
    if constexpr (PH == 3) { for (int i = blockIdx.x; i < 256; i += gridDim.x) cmp_item(p, i, shm); phase_gla_scan(p); }
    if constexpr (PH == 4) phase_p4(p, shm);
    if constexpr (PH == 5) { phase_combine(p); transpose_w2(p, (float*)shm); }
    if constexpr (PH == 6) { run_gemm(shm, (const bf16_t*)(p.ws + WS_A), (const bf16_t*)(p.ws + WS_WOUTT), NTOK, DM, DM, EpiRes{p.x, p.out}); transpose_w13(p, (float*)shm); }
    if constexpr (PH == 7) phase_ln<true>(p, p.ln1_g, p.ln1_b);
    if constexpr (PH == 8) run_gemm(shm, (const bf16_t*)(p.ws + WS_HB), (const bf16_t*)(p.ws + WS_W13T), NTOK, 2 * FFH, DM, EpiGlu{(bf16_t*)(p.ws + WS_U)});
    if constexpr (PH == 9) run_gemm(shm, (const bf16_t*)(p.ws + WS_U), (const bf16_t*)(p.ws + WS_W2T), NTOK, DM, FFH, EpiRes{p.out, p.out});
    if constexpr (PH == 10) phase_ln<false>(p, p.ln2_g, p.ln2_b);
}
template <int PH, int HI, bool ONE>
__device__ __forceinline__ void run_range(const Params& p, unsigned char* shm, const XcdBarrier& xb) {
    if constexpr (PH < HI) {
        run_phase<PH>(p, shm);
        if constexpr (ONE && PH + 1 < HI) { if constexpr (PH == 0) cg::this_grid().sync(); else xcd_barrier(xb); }
#ifdef EXTRA_SYNC
        if constexpr (ONE && PH == 0) { for (int i_ = 0; i_ < EXTRA_SYNC; ++i_) xcd_barrier(xb); }
#endif
        run_range<PH + 1, HI, ONE>(p, shm, xb);
    }
}
template <int LO, int HI, bool ONE>
__global__ __launch_bounds__(512, 2) void mk(Params p) {
    extern __shared__ __attribute__((aligned(16))) unsigned char shm[];
    XcdBarrier xb{};
    if constexpr (ONE) {
        volatile LAS unsigned* st = (volatile LAS unsigned*)(shm + LDS_BYTES - 16);
        if (threadIdx.x == 0) { st[0] = 0u; st[1] = 0u; }
        __syncthreads();
        xb = xcd_barrier_post((unsigned*)(p.ws + WS_BAR), st);
    }
    run_range<LO, HI, ONE>(p, shm, xb);
}
template <int PH> static void launch_one(int grid, const Params& p, hipStream_t stream) {
    static bool attr = false; if (!attr) { (void)hipFuncSetAttribute((const void*)mk<PH, PH + 1, false>, hipFuncAttributeMaxDynamicSharedMemorySize, LDS_BYTES); attr = true; }
    hipLaunchKernelGGL((mk<PH, PH + 1, false>), dim3(grid), dim3(512), LDS_BYTES, stream, p);
}

#ifndef MK_ONE
#define MK_ONE 0
#endif
extern "C" void kernel_launch(void* const* d_in, const int* in_sizes, int n_in, void* d_out, int out_size, void* d_ws, size_t ws_size, hipStream_t stream) {
    static int grid = 0;
    if (grid == 0) {
        if (n_in != 19 || out_size != NTOK * DM || ws_size < WS_END) { fprintf(stderr, "kernel_launch: unexpected shapes (n_in %d out %d ws %zu need %zu)\n", n_in, out_size, ws_size, (size_t)WS_END); grid = -1; return; }
        int dev = 0, cus = 0, per_cu = 0;
        (void)hipGetDevice(&dev); (void)hipDeviceGetAttribute(&cus, hipDeviceAttributeMultiprocessorCount, dev);
        #if MK_ONE
        (void)hipFuncSetAttribute((const void*)mk<0, NPHASE, true>, hipFuncAttributeMaxDynamicSharedMemorySize, LDS_BYTES);
        if (hipOccupancyMaxActiveBlocksPerMultiprocessor(&per_cu, (const void*)mk<0, NPHASE, true>, 512, LDS_BYTES) != hipSuccess || per_cu < 1) { fprintf(stderr, "kernel_launch: occupancy query says %d blocks per CU\n", per_cu); per_cu = 1; }
#endif
        (void)hipGetLastError();
        if (cus <= 0) cus = 256;
        grid = cus;
    }
    if (grid < 0) return;
    Params p{};
    p.x = (const float*)d_in[0]; p.w_in = (const float*)d_in[1]; p.gate_w2 = (const float*)d_in[2]; p.gate_b2 = (const float*)d_in[3]; p.norm_w = (const float*)d_in[4];
    p.ck_pos = (const float*)d_in[5]; p.ck_w1 = (const float*)d_in[6]; p.ck_w2 = (const float*)d_in[7]; p.cv_pos = (const float*)d_in[8]; p.cv_w1 = (const float*)d_in[9]; p.cv_w2 = (const float*)d_in[10];
    p.w_out = (const float*)d_in[11]; p.ln1_g = (const float*)d_in[12]; p.ln1_b = (const float*)d_in[13]; p.ffn_w1 = (const float*)d_in[14]; p.ffn_w3 = (const float*)d_in[15]; p.ffn_w2 = (const float*)d_in[16];
    p.ln2_g = (const float*)d_in[17]; p.ln2_b = (const float*)d_in[18];
    p.out = (float*)d_out; p.ws = (unsigned char*)d_ws;
#if MK_ONE
    (void)hipMemsetAsync((unsigned char*)d_ws + WS_BAR, 0, XCD_BAR_WORDS * 4, stream);
    void* args[] = {&p};
    hipError_t e = hipLaunchCooperativeKernel((const void*)mk<0, NPHASE, true>, dim3(grid), dim3(512), args, LDS_BYTES, stream);
    if (e != hipSuccess) fprintf(stderr, "cooperative launch failed: %s (grid %d)\n", hipGetErrorString(e), grid);
#else
    launch_one<0>(grid, p, stream); launch_one<1>(grid, p, stream); launch_one<2>(grid, p, stream); launch_one<3>(grid, p, stream); launch_one<4>(grid, p, stream); launch_one<5>(grid, p, stream);
    launch_one<6>(grid, p, stream); launch_one<7>(grid, p, stream); launch_one<8>(grid, p, stream); launch_one<9>(grid, p, stream); launch_one<10>(grid, p, stream);
#endif
}
```

```cpp
#include <hip/hip_runtime.h>
#include <hip/hip_cooperative_groups.h>
#include <cstdio>
#include <cstdint>
namespace cg = cooperative_groups;
#define MK_ONE 1
namespace pg8 {
#define PG8_LAS __attribute__((address_space(3)))
typedef unsigned short bf16_t;
typedef short bf16x8 __attribute__((ext_vector_type(8)));
typedef float f32x4 __attribute__((ext_vector_type(4)));
typedef unsigned u32x4 __attribute__((ext_vector_type(4)));
constexpr int BM = 256, BK = 64, HALF = 128, HTB = HALF * BK * 2  , STAGE_BYTES = 8 * HTB, NXCD = 8, WGM = 8;

__host__ __device__ __forceinline__ int lds_byte(int r, int c) { const int st = (r >> 4) * 2 + (c >> 5), rr = r & 15, cc = c & 31, ob = rr * 64 + cc * 2; return st * 1024 + (ob ^ (((ob >> 9) & 1) << 5)); }
__host__ __device__ __forceinline__ void stage_rc(int b, int& R, int& C) { const int st = b / 1024, sb = b % 1024, swz = sb ^ (((sb >> 9) & 1) << 5); R = (st >> 1) * 16 + swz / 64; C = (st & 1) * 32 + (swz % 64) / 2; }
__host__ __device__ __forceinline__ int perm32(int rho) { const int n = rho >> 4, i = rho & 15; return 8 * (i >> 2) + 4 * n + (i & 3); }

struct Unit { int pm, pn; };
struct Gemm { const bf16_t* A; const bf16_t* Bt; int M, N, K; };

struct StaticOrder {
    int nM, nN, nwg, G, c;
    __host__ __device__ void init(int M, int N, int G_, int c_) { nM = M / BM; nN = N / BM; nwg = nM * nN; G = G_; c = c_; }
    __host__ __device__ bool next(int i, Unit& u) const {
        const long L = (long)i * G + c; if (L >= nwg) return false;
        int wgid = (int)L; { const int q = nwg / NXCD, r = nwg % NXCD, xcd = wgid % NXCD, off = wgid / NXCD; wgid = (xcd < r ? xcd * (q + 1) : r * (q + 1) + (xcd - r) * q) + off; }
        const int nig = WGM * nN, gid = wgid / nig, fm = gid * WGM, gsz = (nM - fm) < WGM ? (nM - fm) : WGM;
        u.pm = fm + ((wgid % nig) % gsz); u.pn = (wgid % nig) / gsz; return true;
    }
    __device__ __forceinline__ void a_ready(const Unit&) const {}
    __device__ __forceinline__ void done(const Unit&) const {}
};
struct CountedOrder : StaticOrder {
    const unsigned* ready; unsigned need; unsigned* tmo;
    __device__ __forceinline__ void a_ready(const Unit& u) const {
        if (threadIdx.x < 64) {
            const unsigned long long t0 = __builtin_amdgcn_s_memrealtime(); unsigned polls = 0;
            while ((unsigned)__builtin_amdgcn_readfirstlane(__hip_atomic_load(ready + 64 * u.pm, __ATOMIC_RELAXED, __HIP_MEMORY_SCOPE_AGENT)) < need) {
                if ((++polls & 255u) == 0u && __builtin_amdgcn_readfirstlane(__hip_atomic_load(tmo, __ATOMIC_RELAXED, __HIP_MEMORY_SCOPE_AGENT)) != 0u) break;
                if (__builtin_amdgcn_s_memrealtime() - t0 > 2000000ull) {
                    if (threadIdx.x == 0) { unsigned expect = 0u; __hip_atomic_compare_exchange_strong(tmo + 1, &expect, 0x600u | (unsigned)(u.pm & 0xff), __ATOMIC_RELAXED, __ATOMIC_RELAXED, __HIP_MEMORY_SCOPE_AGENT); __hip_atomic_store(tmo, 1u, __ATOMIC_RELAXED, __HIP_MEMORY_SCOPE_AGENT); }
                    break; }
                __builtin_amdgcn_s_sleep(2); }
            __builtin_amdgcn_fence(__ATOMIC_ACQUIRE, "agent");
            asm volatile("s_waitcnt vmcnt(0)" ::: "memory");
        }
#if !defined(BROKEN_HOOK_NO_BARRIER)
        asm volatile("" ::: "memory"); __builtin_amdgcn_s_barrier(); asm volatile("" ::: "memory");
#endif
    }
};

__device__ __forceinline__ unsigned cvt_pk_bf16(float lo, float hi) { unsigned r; asm volatile("v_cvt_pk_bf16_f32 %0, %1, %2" : "=v"(r) : "v"(lo), "v"(hi)); return r; }
typedef float f32x2 __attribute__((ext_vector_type(2)));
__device__ __forceinline__ f32x2 gelu_pk(f32x2 v) {
    const f32x2 av = __builtin_elementwise_abs(v), d = av * 0.2316418882f + 1.0f;
    f32x2 t; t.x = __builtin_amdgcn_rcpf(d.x); t.y = __builtin_amdgcn_rcpf(d.y);
    f32x2 q = t * 0.5307027145f + (-0.7265760135f); q = q * t + 0.7107068705f; q = q * t + (-0.142248368f); q = q * t + 0.127414796f; q = q * t;
    const f32x2 s = (v * v) * (-0.72134752044f);
    f32x2 e; e.x = __builtin_amdgcn_exp2f(s.x); e.y = __builtin_amdgcn_exp2f(s.y);
    const f32x2 m = v * (q * e), r = v - m;
    f32x2 o; o.x = v.x < 0.f ? m.x : r.x; o.y = v.y < 0.f ? m.y : r.y; return o;
}

struct EpiF32 {
    static constexpr bool PERM = false, AFTER_DRAIN = false;
    float* C; int ldc; const float* bias;
    __device__ __forceinline__ void operator()(const f32x4 (&acc)[2][2][4][2], const Unit& u, int wr, int wc, int fr, int fq) const {
        const int row0 = u.pm * BM + wr * 64 + fr, col0 = u.pn * BM + wc * 32 + 4 * fq;
        f32x4 bv[2][2];
#pragma unroll
        for (int bj = 0; bj < 2; ++bj)
#pragma unroll
            for (int n = 0; n < 2; ++n) bv[bj][n] = bias ? *(const f32x4*)(bias + col0 + bj * HALF + n * 16) : (f32x4){0.f, 0.f, 0.f, 0.f};
#pragma unroll
        for (int ai = 0; ai < 2; ++ai)
#pragma unroll
            for (int m = 0; m < 4; ++m) { float* rowp = C + (size_t)(row0 + ai * HALF + m * 16) * ldc + col0;
#pragma unroll
                for (int bj = 0; bj < 2; ++bj)
#pragma unroll
                    for (int n = 0; n < 2; ++n) *(f32x4*)(rowp + bj * HALF + n * 16) = acc[ai][bj][m][n] + bv[bj][n]; }
    }
};
template <int ACT  > struct EpiBf16 {
    static constexpr bool PERM = true, AFTER_DRAIN = false;
    bf16_t* O; int ldc; const float* bias; int split_cols; size_t split_stride;
    __device__ __forceinline__ void operator()(const f32x4 (&acc)[2][2][4][2], const Unit& u, int wr, int wc, int fr, int fq) const {
        const int row0 = u.pm * BM + wr * 64 + fr; int colt = u.pn * BM; bf16_t* base = O;
        if (split_cols) { const int t = colt / split_cols; base += (size_t)t * split_stride; colt -= t * split_cols; }
        const int col0 = colt + wc * 32 + 8 * fq, bcol0 = u.pn * BM + wc * 32 + 8 * fq;
        f32x4 bv[2][2];
#pragma unroll
        for (int bj = 0; bj < 2; ++bj)
#pragma unroll
            for (int n = 0; n < 2; ++n) bv[bj][n] = bias ? *(const f32x4*)(bias + bcol0 + bj * HALF + 4 * n) : (f32x4){0.f, 0.f, 0.f, 0.f};
#pragma unroll
        for (int ai = 0; ai < 2; ++ai)
#pragma unroll
            for (int m = 0; m < 4; ++m) { bf16_t* rowp = base + (size_t)(row0 + ai * HALF + m * 16) * ldc + col0;
#pragma unroll
                for (int bj = 0; bj < 2; ++bj) { f32x4 v0 = acc[ai][bj][m][0] + bv[bj][0], v1 = acc[ai][bj][m][1] + bv[bj][1];
                    if (ACT == 1) { f32x2 a = gelu_pk((f32x2){v0[0], v0[1]}), b = gelu_pk((f32x2){v0[2], v0[3]}), c = gelu_pk((f32x2){v1[0], v1[1]}), d = gelu_pk((f32x2){v1[2], v1[3]});
                        v0 = (f32x4){a.x, a.y, b.x, b.y}; v1 = (f32x4){c.x, c.y, d.x, d.y}; }
                    if (ACT == 2) {
#pragma unroll
                        for (int j = 0; j < 4; ++j) { v0[j] = 0.5f * v0[j] * (1.0f + erff(v0[j] * 0.70710678f)); v1[j] = 0.5f * v1[j] * (1.0f + erff(v1[j] * 0.70710678f)); } }
                    u32x4 w; w.x = cvt_pk_bf16(v0[0], v0[1]); w.y = cvt_pk_bf16(v0[2], v0[3]); w.z = cvt_pk_bf16(v1[0], v1[1]); w.w = cvt_pk_bf16(v1[2], v1[3]);
                    *(u32x4*)(rowp + bj * HALF) = w; } }
    }
};

struct PanelStats {
    unsigned* xbuf;
    unsigned* cnt;
    unsigned* tmo;
    int ntn; float eps;
    unsigned code;
    __device__ __forceinline__ bool run(const f32x4 (&v)[2][2][4][2], const Unit& u, int wr, int wc, int fr, int fq, PG8_LAS unsigned char* lds, int wid, int lane) const {
        typedef float f32x2v __attribute__((ext_vector_type(2)));
        PG8_LAS f32x2v* P = (PG8_LAS f32x2v*)lds;
        PG8_LAS f32x2v* S = (PG8_LAS f32x2v*)(lds + 8192);
        PG8_LAS unsigned* flag = (PG8_LAS unsigned*)(lds + 8192 + 2048);
#pragma unroll
        for (int ai = 0; ai < 2; ++ai)
#pragma unroll
            for (int m = 0; m < 4; ++m) {
                float s = 0.f;
#pragma unroll
                for (int bj = 0; bj < 2; ++bj)
#pragma unroll
                    for (int n = 0; n < 2; ++n) { const f32x4 x = v[ai][bj][m][n]; s += (x[0] + x[1]) + (x[2] + x[3]); }
                s += __shfl_xor(s, 16); s += __shfl_xor(s, 32);
                const float mw = s * (1.0f / 64.0f); float q = 0.f;
#pragma unroll
                for (int bj = 0; bj < 2; ++bj)
#pragma unroll
                    for (int n = 0; n < 2; ++n) { const f32x4 d = v[ai][bj][m][n] - mw; q += (d[0] * d[0] + d[1] * d[1]) + (d[2] * d[2] + d[3] * d[3]); }
                q += __shfl_xor(q, 16); q += __shfl_xor(q, 32);
                if (fq == 0) P[(ai * HALF + wr * 64 + m * 16 + fr) * 4 + wc] = (f32x2v){mw, q};
            }
        asm volatile("s_waitcnt lgkmcnt(0)" ::: "memory"); __builtin_amdgcn_s_barrier(); asm volatile("" ::: "memory");
#if defined(BROKEN_NO_WAIT)
        if (blockIdx.x >= 64) { const long long t0 = clock64(); while (clock64() - t0 < 60000) __builtin_amdgcn_s_sleep(8); }
#endif
        const int row = wid * 32 + (lane & 31);
        if (lane < 32) {
            const f32x2v a = P[row * 4 + 0], b = P[row * 4 + 1], c = P[row * 4 + 2], d = P[row * 4 + 3];
            const float mt = (a.x + b.x + c.x + d.x) * 0.25f;
            const float da = a.x - mt, db = b.x - mt, dc = c.x - mt, dd = d.x - mt;
            const float m2 = (a.y + b.y) + (c.y + d.y) + 64.0f * ((da * da + db * db) + (dc * dc + dd * dd));
            unsigned long long* slot = (unsigned long long*)xbuf + ((size_t)(u.pm * BM + row) * 4 + u.pn);
            __hip_atomic_store(slot, ((unsigned long long)__float_as_uint(m2) << 32) | __float_as_uint(mt), __ATOMIC_RELAXED, __HIP_MEMORY_SCOPE_AGENT);
        }
        asm volatile("s_waitcnt vmcnt(0)" ::: "memory");
        if (lane == 0) __hip_atomic_fetch_add(cnt + 64 * u.pm, 1u, __ATOMIC_RELAXED, __HIP_MEMORY_SCOPE_AGENT);
        if (wid == 0) {
            bool dead = false; const unsigned long long t0 = __builtin_amdgcn_s_memrealtime(); const unsigned want = 8u * (unsigned)ntn;
            for (;;) {
#if defined(BROKEN_NO_WAIT)
                break;
#endif
                if ((unsigned)__builtin_amdgcn_readfirstlane(__hip_atomic_load(cnt + 64 * u.pm, __ATOMIC_RELAXED, __HIP_MEMORY_SCOPE_AGENT)) >= want) break;
                if (__builtin_amdgcn_s_memrealtime() - t0 > 2000000ull) {
                    if (lane == 0) { unsigned expect = 0u; __hip_atomic_compare_exchange_strong(tmo + 1, &expect, code | (unsigned)(u.pm & 0xff), __ATOMIC_RELAXED, __ATOMIC_RELAXED, __HIP_MEMORY_SCOPE_AGENT);
                                     __hip_atomic_store(tmo, 1u, __ATOMIC_RELAXED, __HIP_MEMORY_SCOPE_AGENT); }
                    dead = true; break; }
                __builtin_amdgcn_s_sleep(2);
            }
            __builtin_amdgcn_fence(__ATOMIC_ACQUIRE, "agent");
            if (lane == 0) flag[0] = dead ? 1u : 0u;
        }
        asm volatile("s_waitcnt vmcnt(0) lgkmcnt(0)" ::: "memory"); __builtin_amdgcn_s_barrier(); asm volatile("" ::: "memory");
        const bool bad = flag[0] != 0u;
        if (lane < 32) {
            const unsigned long long* slot = (const unsigned long long*)xbuf + (size_t)(u.pm * BM + row) * 4; float mt[4], m2[4]; float ms = 0.f;
#pragma unroll
            for (int t = 0; t < 4; ++t) { if (t < ntn) { const unsigned long long w = __hip_atomic_load(slot + t, __ATOMIC_RELAXED, __HIP_MEMORY_SCOPE_AGENT); mt[t] = __uint_as_float((unsigned)w); m2[t] = __uint_as_float((unsigned)(w >> 32)); } else { mt[t] = 0.f; m2[t] = 0.f; } ms += mt[t]; }
            const float mean = ms / (float)ntn; float q = 0.f;
#pragma unroll
            for (int t = 0; t < 4; ++t) if (t < ntn) { const float dm = mt[t] - mean; q += m2[t] + 256.0f * dm * dm; }
            S[row] = (f32x2v){mean, 1.0f / sqrtf(q / (256.0f * (float)ntn) + eps)};
        }
        asm volatile("s_waitcnt lgkmcnt(0)" ::: "memory"); __builtin_amdgcn_s_barrier(); asm volatile("" ::: "memory");
        return bad;
    }
};
struct EpiLnRes {
    static constexpr bool PERM = false, AFTER_DRAIN = true;
    const float* base; float* out; int ldc; const float* bias; PanelStats st; unsigned poison;
    __device__ __forceinline__ void refuse(size_t i0, size_t stride, int M, int N) const { const float q = __builtin_nanf(""); for (size_t i = i0; i < (size_t)M * N; i += stride) out[(i / N) * ldc + i % N] = q;
        if (i0 == 0) { unsigned expect = 0u; __hip_atomic_compare_exchange_strong(st.tmo + 1, &expect, 0x7f0u, __ATOMIC_RELAXED, __ATOMIC_RELAXED, __HIP_MEMORY_SCOPE_AGENT); __hip_atomic_store(st.tmo, 1u, __ATOMIC_RELAXED, __HIP_MEMORY_SCOPE_AGENT); } }
    __device__ __forceinline__ void fused(f32x4 (&acc)[2][2][4][2], const Unit& u, int wr, int wc, int fr, int fq, PG8_LAS unsigned char* lds, int wid, int lane) const {
        typedef float f32x2v __attribute__((ext_vector_type(2)));
        const PG8_LAS f32x2v* S = (const PG8_LAS f32x2v*)(lds + 8192);
        const int col0 = u.pn * BM + wc * 32 + 4 * fq;
#pragma unroll
        for (int bj = 0; bj < 2; ++bj)
#pragma unroll
            for (int n = 0; n < 2; ++n) { const f32x4 bv = bias ? *(const f32x4*)(bias + col0 + bj * HALF + n * 16) : (f32x4){0.f, 0.f, 0.f, 0.f};
#pragma unroll
                for (int ai = 0; ai < 2; ++ai)
#pragma unroll
                    for (int m = 0; m < 4; ++m) acc[ai][bj][m][n] += bv; }
        const bool bad = st.run(acc, u, wr, wc, fr, fq, lds, wid, lane) || poison != 0u;
        const float qnan = __builtin_nanf("");
#pragma unroll
        for (int ai = 0; ai < 2; ++ai)
#pragma unroll
            for (int m = 0; m < 4; ++m) { const int r = ai * HALF + wr * 64 + m * 16 + fr; const f32x2v sr = S[r]; const size_t off = (size_t)(u.pm * BM + r) * ldc + col0;
#pragma unroll
                for (int bj = 0; bj < 2; ++bj)
#pragma unroll
                    for (int n = 0; n < 2; ++n) { const f32x4 bs = *(const f32x4*)(base + off + bj * HALF + n * 16); f32x4 o = bs + (acc[ai][bj][m][n] - sr.x) * sr.y;
                        if (bad) o = (f32x4){qnan, qnan, qnan, qnan}; *(f32x4*)(out + off + bj * HALF + n * 16) = o; }
                asm volatile("" ::: "memory"); }
    }
};
struct EpiLnResLn {
    static constexpr bool PERM = false, AFTER_DRAIN = true;
    const float* base; float* out; bf16_t* xn; int ldc; const float* bias; PanelStats st1, st2; unsigned poison;
    __device__ __forceinline__ void refuse(size_t i0, size_t stride, int M, int N) const { const float q = __builtin_nanf(""); for (size_t i = i0; i < (size_t)M * N; i += stride) { const size_t o = (i / N) * ldc + i % N; out[o] = q; xn[o] = (bf16_t)0x7fc0u; }
        if (i0 == 0) { unsigned expect = 0u; __hip_atomic_compare_exchange_strong(st1.tmo + 1, &expect, 0x7f0u, __ATOMIC_RELAXED, __ATOMIC_RELAXED, __HIP_MEMORY_SCOPE_AGENT); __hip_atomic_store(st1.tmo, 1u, __ATOMIC_RELAXED, __HIP_MEMORY_SCOPE_AGENT); } }
    __device__ __forceinline__ void fused(f32x4 (&acc)[2][2][4][2], const Unit& u, int wr, int wc, int fr, int fq, PG8_LAS unsigned char* lds, int wid, int lane) const {
        typedef float f32x2v __attribute__((ext_vector_type(2))); typedef unsigned u32x2v __attribute__((ext_vector_type(2)));
        const PG8_LAS f32x2v* S = (const PG8_LAS f32x2v*)(lds + 8192);
        const int col0 = u.pn * BM + wc * 32 + 4 * fq;
#pragma unroll
        for (int bj = 0; bj < 2; ++bj)
#pragma unroll
            for (int n = 0; n < 2; ++n) { const f32x4 bv = bias ? *(const f32x4*)(bias + col0 + bj * HALF + n * 16) : (f32x4){0.f, 0.f, 0.f, 0.f};
#pragma unroll
                for (int ai = 0; ai < 2; ++ai)
#pragma unroll
                    for (int m = 0; m < 4; ++m) acc[ai][bj][m][n] += bv; }
        bool bad = st1.run(acc, u, wr, wc, fr, fq, lds, wid, lane) || poison != 0u;
        const float qnan = __builtin_nanf("");
#pragma unroll
        for (int ai = 0; ai < 2; ++ai)
#pragma unroll
            for (int m = 0; m < 4; ++m) { const int r = ai * HALF + wr * 64 + m * 16 + fr; const f32x2v sr = S[r]; const size_t off = (size_t)(u.pm * BM + r) * ldc + col0;
#pragma unroll
                for (int bj = 0; bj < 2; ++bj)
#pragma unroll
                    for (int n = 0; n < 2; ++n) { const f32x4 bs = *(const f32x4*)(base + off + bj * HALF + n * 16); acc[ai][bj][m][n] = bs + (acc[ai][bj][m][n] - sr.x) * sr.y; }
                asm volatile("" : "+v"(acc[ai][0][m][0]), "+v"(acc[ai][0][m][1]), "+v"(acc[ai][1][m][0]), "+v"(acc[ai][1][m][1]));
                if (m & 1) asm volatile("" ::: "memory"); }
        const bool bad1 = bad;
        bad = st2.run(acc, u, wr, wc, fr, fq, lds, wid, lane) || bad;
#pragma unroll
        for (int ai = 0; ai < 2; ++ai)
#pragma unroll
            for (int m = 0; m < 4; ++m) { const int r = ai * HALF + wr * 64 + m * 16 + fr; const f32x2v sr = S[r]; const size_t off = (size_t)(u.pm * BM + r) * ldc + col0;
#pragma unroll
                for (int bj = 0; bj < 2; ++bj)
#pragma unroll
                    for (int n = 0; n < 2; ++n) { const f32x4 x1 = acc[ai][bj][m][n]; *(f32x4*)(out + off + bj * HALF + n * 16) = bad1 ? (f32x4){qnan, qnan, qnan, qnan} : x1;
                        const f32x4 o = (x1 - sr.x) * sr.y; u32x2v w; w.x = cvt_pk_bf16(o[0], o[1]); w.y = cvt_pk_bf16(o[2], o[3]);
                        if (bad) { w.x = 0x7fc07fc0u; w.y = 0x7fc07fc0u; } *(u32x2v*)(xn + off + bj * HALF + n * 16) = w; }
                asm volatile("" ::: "memory"); }
    }
};

template <class Epi, class Sched, bool STAMP = false>
__device__ __forceinline__ void gemm_phase(PG8_LAS unsigned char* lds, const Gemm g, const Sched& S, const Epi& E, unsigned long long* stamps) {
    const int tid = threadIdx.x, wid = __builtin_amdgcn_readfirstlane(tid >> 6), lane = tid & 63, wr = wid >> 2, wc = wid & 3, fr = lane & 15, fq = lane >> 4;
    const int K = g.K, nt = K / BK;
    int ts_lo = 0, ts_hi = 0, nts = 0; const unsigned long long rt_entry = STAMP ? (unsigned long long)wall_clock64() : 0ull;
#define PG8_STAMP() do { if (STAMP && wid == 0 && nts < 64) { const unsigned long long _c = (unsigned long long)clock64(); \
        ts_lo = (lane == nts) ? (int)(unsigned)_c : ts_lo; ts_hi = (lane == nts) ? (int)(unsigned)(_c >> 32) : ts_hi; ++nts; } } while (0)
    PG8_STAMP();
    unsigned voffA[2], voffB[2];
#pragma unroll
    for (int i = 0; i < 2; ++i) { int R, C; stage_rc(tid * 16 + i * 8192, R, C); const int Rb = Epi::PERM ? ((R & ~31) + perm32(R & 31)) : R;
        voffA[i] = (unsigned)(R * K + C) * 2u; voffB[i] = (unsigned)(Rb * K + C) * 2u; }
    const size_t kstep = (size_t)(BK * 2);
    const size_t hstep = (size_t)HALF * K * 2;
    const size_t tstep = 2 * hstep;
    const unsigned ldsw = (unsigned)wid * 1024u;
    const int aoff = lds_byte(wr * 64 + fr, fq * 8), boff = lds_byte(wc * 32 + fr, fq * 8);
#define PG8_SA(b, h) (((b) * 2 + (h)) * HTB)
#define PG8_SB(b, h) ((4 + (b) * 2 + (h)) * HTB)
#define PG8_STAGE(bufoff, gbase, voff) do { _Pragma("unroll") for (int _i = 0; _i < 2; ++_i) \
        __builtin_amdgcn_global_load_lds((const unsigned*)((const char*)(gbase) + (voff)[_i]), (PG8_LAS unsigned*)(lds + (bufoff) + ldsw + _i * 8192), 16, 0, 0); } while (0)
#define PG8_LDA(dst, b, h) do { _Pragma("unroll") for (int m = 0; m < 4; ++m) _Pragma("unroll") for (int k = 0; k < 2; ++k) dst[m][k] = *(const PG8_LAS bf16x8*)(lds + PG8_SA(b, h) + aoff + m * 2048 + k * 1024); } while (0)
#define PG8_LDB(dst, b, h) do { _Pragma("unroll") for (int n = 0; n < 2; ++n) _Pragma("unroll") for (int k = 0; k < 2; ++k) dst[n][k] = *(const PG8_LAS bf16x8*)(lds + PG8_SB(b, h) + boff + n * 2048 + k * 1024); } while (0)
#define PG8_MMA(ai, bj, At, Bt) do { __builtin_amdgcn_s_setprio(1); _Pragma("unroll") for (int m = 0; m < 4; ++m) _Pragma("unroll") for (int n = 0; n < 2; ++n) _Pragma("unroll") for (int k = 0; k < 2; ++k) \
        acc[ai][bj][m][n] = __builtin_amdgcn_mfma_f32_16x16x32_bf16(Bt[n][k], At[m][k], acc[ai][bj][m][n], 0, 0, 0); __builtin_amdgcn_s_setprio(0); } while (0)
#define PG8_WAIT_V(n) asm volatile("s_waitcnt vmcnt(" #n ")" ::: "memory")
#define PG8_WAIT_L(n) asm volatile("s_waitcnt lgkmcnt(" #n ")" ::: "memory")
#define PG8_BAR __builtin_amdgcn_s_barrier()
#define PG8_SCHED __builtin_amdgcn_sched_barrier(0)
    Unit cur, nxt; int ui = 0;
    if (!S.next(0, cur)) return;
    f32x4 acc[2][2][4][2];
#pragma unroll
    for (int a = 0; a < 2; ++a)
#pragma unroll
        for (int b = 0; b < 2; ++b)
#pragma unroll
            for (int m = 0; m < 4; ++m)
#pragma unroll
                for (int n = 0; n < 2; ++n) acc[a][b][m][n] = (f32x4){0.f, 0.f, 0.f, 0.f};
    bf16x8 At[4][2], B0[2][2], B1[2][2];
    const char* cA = (const char*)g.A + (size_t)cur.pm * tstep; const char* cB = (const char*)g.Bt + (size_t)cur.pn * tstep;
    S.a_ready(cur);
    PG8_STAGE(PG8_SB(0, 0), cB, voffB); PG8_STAGE(PG8_SA(0, 0), cA, voffA); PG8_STAGE(PG8_SB(0, 1), cB + hstep, voffB); PG8_STAGE(PG8_SA(0, 1), cA + hstep, voffA);
    if (wr == 1) PG8_BAR;
    PG8_WAIT_V(4); PG8_BAR;
    PG8_STAGE(PG8_SB(1, 0), cB + kstep, voffB); PG8_STAGE(PG8_SA(1, 0), cA + kstep, voffA); PG8_STAGE(PG8_SB(1, 1), cB + hstep + kstep, voffB);
    PG8_WAIT_V(6); PG8_BAR;
    PG8_STAMP();
    for (;;) {
        const bool has_next = S.next(ui + 1, nxt);
        const char* nA = has_next ? (const char*)g.A + (size_t)nxt.pm * tstep : cA; const char* nB = has_next ? (const char*)g.Bt + (size_t)nxt.pn * tstep : cB;
        for (int t = 0; t < nt; t += 2) {
            const bool last = (t == nt - 2);
            const char* a1 = cA + (size_t)(t + 1) * kstep;
            const char* a2 = last ? nA : cA + (size_t)(t + 2) * kstep; const char* b2 = last ? nB : cB + (size_t)(t + 2) * kstep;
            const char* a3 = a2 + kstep; const char* b3 = b2 + kstep;
            if (last && has_next) S.a_ready(nxt);
            PG8_LDB(B0, 0, 0); PG8_SCHED; PG8_LDA(At, 0, 0); PG8_STAGE(PG8_SA(1, 1), a1 + hstep, voffA);
            PG8_WAIT_L(8); PG8_BAR; PG8_WAIT_L(0); PG8_MMA(0, 0, At, B0); PG8_BAR; PG8_SCHED;
            PG8_LDB(B1, 0, 1); PG8_STAGE(PG8_SB(0, 0), b2, voffB);
            PG8_BAR; PG8_WAIT_L(0); PG8_MMA(0, 1, At, B1); PG8_BAR;
            PG8_LDA(At, 0, 1); PG8_STAGE(PG8_SA(0, 0), a2, voffA);
            PG8_BAR; PG8_WAIT_L(0); PG8_MMA(1, 0, At, B0); PG8_BAR; PG8_SCHED;
            PG8_STAGE(PG8_SB(0, 1), b2 + hstep, voffB);
            PG8_WAIT_V(6); PG8_BAR; PG8_MMA(1, 1, At, B1); PG8_BAR;
            PG8_LDB(B0, 1, 0); PG8_SCHED; PG8_LDA(At, 1, 0); PG8_STAGE(PG8_SA(0, 1), a2 + hstep, voffA);
            PG8_WAIT_L(8); PG8_BAR; PG8_WAIT_L(0); PG8_MMA(0, 0, At, B0); PG8_BAR; PG8_SCHED;
            PG8_LDB(B1, 1, 1); PG8_STAGE(PG8_SB(1, 0), b3, voffB);
            PG8_BAR; PG8_WAIT_L(0); PG8_MMA(0, 1, At, B1); PG8_BAR;
            PG8_LDA(At, 1, 1); PG8_STAGE(PG8_SA(1, 0), a3, voffA);
            PG8_BAR; PG8_WAIT_L(0); PG8_MMA(1, 0, At, B0); PG8_BAR; PG8_SCHED;
            PG8_STAGE(PG8_SB(1, 1), b3 + hstep, voffB);
            PG8_WAIT_V(6); PG8_BAR; PG8_MMA(1, 1, At, B1); PG8_BAR;
        }
        PG8_STAMP();
        if constexpr (!Epi::AFTER_DRAIN) { E(acc, cur, wr, wc, fr, fq); S.done(cur); }
        PG8_STAMP();
        if (!has_next) break;
#pragma unroll
        for (int a = 0; a < 2; ++a)
#pragma unroll
            for (int b = 0; b < 2; ++b)
#pragma unroll
                for (int m = 0; m < 4; ++m)
#pragma unroll
                    for (int n = 0; n < 2; ++n) acc[a][b][m][n] = (f32x4){0.f, 0.f, 0.f, 0.f};
        cur = nxt; cA = nA; cB = nB; ++ui;
    }
    PG8_WAIT_V(0);
    if (wr == 0) PG8_BAR;
    PG8_BAR;
    if constexpr (Epi::AFTER_DRAIN) { E.fused(acc, cur, wr, wc, fr, fq, lds, wid, lane); S.done(cur); }
    PG8_STAMP();
    if (STAMP && wid == 0) { stamps[lane] = lane < nts ? (((unsigned long long)(unsigned)ts_hi << 32) | (unsigned)ts_lo) : 0ull;
        if (lane == 62) stamps[62] = rt_entry; if (lane == 63) stamps[63] = (unsigned long long)wall_clock64(); }
#undef PG8_STAMP
#undef PG8_SA
#undef PG8_SB
#undef PG8_STAGE
#undef PG8_LDA
#undef PG8_LDB
#undef PG8_MMA
#undef PG8_WAIT_V
#undef PG8_WAIT_L
#undef PG8_BAR
#undef PG8_SCHED
}
}

#define XB_TMO      128
#define XB_XCNT(j)  (256  + 64 * (j))
#define XB_XSUB(j)  (1280 + 64 * (j))
#define XB_XGEN(j)  (2304 + 64 * (j))
#define XB_TOP      3328
#define XB_TOPGEN   3392
#define XCD_BAR_WORDS 3456
#define XB_SPIN_CAP (1u << 18)
#define LAS __attribute__((address_space(3)))

__device__ __forceinline__ unsigned xb_ld(unsigned* p)              { return __hip_atomic_load(p, __ATOMIC_RELAXED, __HIP_MEMORY_SCOPE_AGENT); }
__device__ __forceinline__ unsigned xb_add(unsigned* p, unsigned v) { return __hip_atomic_fetch_add(p, v, __ATOMIC_RELAXED, __HIP_MEMORY_SCOPE_AGENT); }
__device__ __forceinline__ unsigned xb_xcc_id() { return (unsigned)__builtin_amdgcn_s_getreg((3 << 11) | 20) & 0xFu; }
#define XB_SPIN(cond, bar) do { unsigned _sp = 0; while (cond) { __builtin_amdgcn_s_sleep(1); \
    if ((++_sp & 255u) == 0u) { if (xb_ld(&(bar)[XB_TMO])) break; if (_sp > XB_SPIN_CAP) { atomicAdd(&(bar)[XB_TMO], 1u); break; } } } } while (0)

struct XcdBarrier {
    unsigned* bar; unsigned x;
    volatile LAS unsigned* st;
};

__device__ __forceinline__ XcdBarrier xcd_barrier_post(unsigned* bar, volatile LAS unsigned* st) {
    XcdBarrier b; b.bar = bar; b.x = xb_xcc_id(); b.st = st;
    if (threadIdx.x == 0) (void)xb_add(&bar[XB_XCNT(b.x)], 1u);
    return b;
}
__device__ __forceinline__ void xcd_barrier_complete(unsigned* bar, unsigned x, unsigned& nloc, unsigned& nx) {
    const unsigned G = gridDim.x * gridDim.y * gridDim.z;
    unsigned sum, cnt, mine, sp = 0u;
    for (;;) {
        sum = 0u; cnt = 0u; mine = 0u;
#pragma unroll
        for (unsigned j = 0; j < 16; ++j) { const unsigned c = xb_ld(&bar[XB_XCNT(j)]); sum += c; cnt += (c > 0u) ? 1u : 0u; mine = (j == x) ? c : mine; }
        if (sum == G) break;
        __builtin_amdgcn_s_sleep(1);
        if ((++sp & 255u) == 0u) { if (xb_ld(&bar[XB_TMO])) break; if (sp > XB_SPIN_CAP) { atomicAdd(&bar[XB_TMO], 1u); break; } }
    }
    nloc = mine > 0u ? mine : 1u; nx = cnt > 0u ? cnt : 1u;
}

__device__ __forceinline__ void xcd_barrier(const XcdBarrier& b) {
    asm volatile("s_waitcnt vmcnt(0)" ::: "memory");
    __syncthreads();
    if (threadIdx.x == 0) {
        unsigned* bar = b.bar;
        __builtin_amdgcn_s_waitcnt(0);
        unsigned nloc = b.st[0], nx = b.st[1];
        if (nloc == 0u) { xcd_barrier_complete(bar, b.x, nloc, nx); b.st[0] = nloc; b.st[1] = nx; }
        const unsigned old = xb_add(&bar[XB_XSUB(b.x)], 1u);
        const unsigned gen = old / nloc;
        if (old + 1u == (gen + 1u) * nloc) {
            __builtin_amdgcn_fence(__ATOMIC_RELEASE, "agent");
            asm volatile("s_waitcnt vmcnt(0)" ::: "memory");
            const unsigned og = xb_add(&bar[XB_TOP], 1u);
            const unsigned tg = og / nx;
            if (og + 1u == (tg + 1u) * nx) xb_add(&bar[XB_TOPGEN], 1u);
            else XB_SPIN(xb_ld(&bar[XB_TOPGEN]) == tg, bar);
            __builtin_amdgcn_fence(__ATOMIC_ACQUIRE, "agent");
            xb_add(&bar[XB_XGEN(b.x)], 1u);
            asm volatile("s_waitcnt vmcnt(0)" ::: "memory");
        } else {
            XB_SPIN(xb_ld(&bar[XB_XGEN(b.x)]) == gen, bar);
            __builtin_amdgcn_fence(__ATOMIC_ACQUIRE, "agent");
            asm volatile("s_waitcnt vmcnt(0)" ::: "memory");
        }
    }
    __syncthreads();
}


typedef unsigned short bf16_t;
typedef short bf16x8 __attribute__((ext_vector_type(8)));
typedef short s16x4 __attribute__((ext_vector_type(4)));
typedef float f32x4 __attribute__((ext_vector_type(4)));
typedef float f32x16 __attribute__((ext_vector_type(16)));
typedef unsigned u32x4 __attribute__((ext_vector_type(4)));
typedef unsigned u32x2 __attribute__((ext_vector_type(2)));

constexpr int NB = 4, SEQ = 2048, DM = 2048, NTOK = NB * SEQ;
constexpr int INW = 5672, UW = 5888, FFH = 5632;
constexpr float ALPHA = 1.189207115002721f;
constexpr float LN_EPS = 1e-5f;
constexpr int LDS_BYTES = 131072 + 8192;

constexpr size_t CH_BYTES = (size_t)NTOK * 128 * 2;
constexpr size_t WS_U = 0;
constexpr size_t WS_R1 = 45 * CH_BYTES;
constexpr size_t WS_XB = WS_R1;
constexpr size_t WS_WINT = WS_XB + (size_t)NTOK * DM * 2;
constexpr size_t WS_QR = WS_R1;
constexpr size_t WS_DS = WS_QR + 8 * CH_BYTES;
constexpr size_t WS_DECAY = WS_DS + (size_t)16 * 32 * 256 * 128 * 2;
constexpr size_t WS_KCMP = WS_DECAY + (size_t)16 * 32 * 128 * 4;
constexpr size_t WS_MASK = WS_KCMP + (size_t)2 * 4 * 2 * 128 * 128 * 2;
constexpr size_t WS_HB = WS_R1;
constexpr size_t WS_W2T = WS_HB + (size_t)NTOK * DM * 2;
constexpr size_t WS_R2 = WS_R1 + (size_t)NTOK * DM * 2 + (size_t)UW * DM * 2;
constexpr size_t WS_OP = WS_R2;
constexpr size_t WS_W13T = WS_R2;
constexpr size_t WS_A = WS_R2 + (size_t)3 * NTOK * 1024 * 2;
constexpr size_t WS_WOUTT = WS_A + (size_t)NTOK * DM * 2;
constexpr size_t WS_CW1T = WS_WOUTT + (size_t)DM * DM * 2;
constexpr size_t WS_CW2T = WS_CW1T + (size_t)2 * 256 * 4096 * 2;
constexpr size_t WS_C1P = WS_CW2T + (size_t)2 * 128 * 256 * 2;
constexpr size_t WS_ROPE = WS_C1P + (size_t)2 * 16 * 256 * 4;
constexpr size_t WS_BAR = WS_ROPE + (size_t)2 * 2048 * 16 * 4;
constexpr size_t WS_END = WS_BAR + 16384;

struct Params {
    const float* x; const float* w_in; const float* gate_w2; const float* gate_b2; const float* norm_w;
    const float* ck_pos; const float* ck_w1; const float* ck_w2; const float* cv_pos; const float* cv_w1; const float* cv_w2;
    const float* w_out; const float* ln1_g; const float* ln1_b; const float* ffn_w1; const float* ffn_w3; const float* ffn_w2;
    const float* ln2_g; const float* ln2_b;
    float* out; unsigned char* ws;
};

typedef __bf16 bf16x2_t __attribute__((ext_vector_type(2)));
typedef float f32x2_t __attribute__((ext_vector_type(2)));
__device__ __forceinline__ unsigned cvtpk(float lo, float hi) { f32x2_t v = {lo, hi}; bf16x2_t b = __builtin_convertvector(v, bf16x2_t); return __builtin_bit_cast(unsigned, b); }
__device__ __forceinline__ int otid() { int t = threadIdx.x; asm volatile("" : "+v"(t)); return t; }
__device__ __forceinline__ float bf2f(bf16_t b) { return __uint_as_float(((unsigned)b) << 16); }
__device__ __forceinline__ bf16_t f2bf(float f) { return (bf16_t)(cvtpk(f, 0.f) & 0xffffu); }
__device__ __forceinline__ float bflo(unsigned w) { return __uint_as_float(w << 16); }
__device__ __forceinline__ float bfhi(unsigned w) { return __uint_as_float(w & 0xffff0000u); }
__device__ __forceinline__ float sigmoidf_(float z) { return 1.0f / (1.0f + __expf(-z)); }
#define MFMA32(a, b, c) __builtin_amdgcn_mfma_f32_32x32x16_bf16((a), (b), (c), 0, 0, 0)
__device__ __forceinline__ int crow(int r, int hi) { return (r & 3) + 8 * (r >> 2) + 4 * hi; }
__device__ __forceinline__ bf16_t* uchunk(const Params& p, int c) { return (bf16_t*)(p.ws + WS_U + (size_t)c * CH_BYTES); }

struct EpiU {
    static constexpr bool PERM = true, AFTER_DRAIN = false;
    bf16_t* U;
    __device__ __forceinline__ void operator()(const pg8::f32x4 (&acc)[2][2][4][2], const pg8::Unit& u, int wr, int wc, int fr, int fq) const {
        const int row0 = u.pm * 256 + wr * 64 + fr;
#pragma unroll
        for (int bj = 0; bj < 2; ++bj) {
            const int ch = u.pn * 2 + bj; if (ch >= 45) continue;
            bf16_t* base = U + (size_t)ch * NTOK * 128 + wc * 32 + 8 * fq;
#pragma unroll
            for (int ai = 0; ai < 2; ++ai)
#pragma unroll
                for (int m = 0; m < 4; ++m) {
                    const pg8::f32x4 v0 = acc[ai][bj][m][0], v1 = acc[ai][bj][m][1];
                    u32x4 w; w.x = cvtpk(v0[0], v0[1]); w.y = cvtpk(v0[2], v0[3]); w.z = cvtpk(v1[0], v1[1]); w.w = cvtpk(v1[2], v1[3]);
                    *(u32x4*)(base + (size_t)(row0 + ai * 128 + m * 16) * 128) = w; }
        }
    }
};
struct EpiRes {
    static constexpr bool PERM = false, AFTER_DRAIN = false;
    const float* R; float* out;
    __device__ __forceinline__ void operator()(const pg8::f32x4 (&acc)[2][2][4][2], const pg8::Unit& u, int wr, int wc, int fr, int fq) const {
        const int row0 = u.pm * 256 + wr * 64 + fr, col0 = u.pn * 256 + wc * 32 + 4 * fq;
#pragma unroll
        for (int ai = 0; ai < 2; ++ai)
#pragma unroll
            for (int m = 0; m < 4; ++m) { const size_t off = (size_t)(row0 + ai * 128 + m * 16) * DM + col0;
#pragma unroll
                for (int bj = 0; bj < 2; ++bj)
#pragma unroll
                    for (int n = 0; n < 2; ++n) { const pg8::f32x4 r = *(const pg8::f32x4*)(R + off + bj * 128 + n * 16);
                        *(pg8::f32x4*)(out + off + bj * 128 + n * 16) = r * ALPHA + acc[ai][bj][m][n]; } }
    }
};
struct EpiGlu {
    static constexpr bool PERM = true, AFTER_DRAIN = false;
    bf16_t* T;
    __device__ __forceinline__ void operator()(const pg8::f32x4 (&acc)[2][2][4][2], const pg8::Unit& u, int wr, int wc, int fr, int fq) const {
        const int row0 = u.pm * 256 + wr * 64 + fr, col0 = u.pn * 128 + wc * 32 + 8 * fq;
#pragma unroll
        for (int ai = 0; ai < 2; ++ai)
#pragma unroll
            for (int m = 0; m < 4; ++m) {
                float t[8];
#pragma unroll
                for (int n = 0; n < 2; ++n)
#pragma unroll
                    for (int j = 0; j < 4; ++j) { const float a = acc[ai][0][m][n][j], b = acc[ai][1][m][n][j]; t[n * 4 + j] = a * b / (1.0f + __expf(-a)); }
                u32x4 w; w.x = cvtpk(t[0], t[1]); w.y = cvtpk(t[2], t[3]); w.z = cvtpk(t[4], t[5]); w.w = cvtpk(t[6], t[7]);
                *(u32x4*)(T + (size_t)(row0 + ai * 128 + m * 16) * FFH + col0) = w; }
    }
};

__device__ __forceinline__ void tr_tile(const float* src, int ld, int sc, bf16_t* dst, int dstK, int n0, int k0, float* tile) {
    const int tid = otid(), lane = tid & 63, w = __builtin_amdgcn_readfirstlane(tid >> 6);
#pragma unroll
    for (int i = 0; i < 8; ++i) { const int k = w * 8 + i; tile[k * 65 + lane] = sc >= 0 ? src[(size_t)(k0 + k) * ld + sc] : 0.f; }
    __syncthreads();
    const int n = tid >> 3, k8 = (tid & 7) * 8;
    float v[8];
#pragma unroll
    for (int i = 0; i < 8; ++i) v[i] = tile[(k8 + i) * 65 + n];
    u32x4 w4; w4.x = cvtpk(v[0], v[1]); w4.y = cvtpk(v[2], v[3]); w4.z = cvtpk(v[4], v[5]); w4.w = cvtpk(v[6], v[7]);
    *(u32x4*)(dst + (size_t)(n0 + n) * dstK + k0 + k8) = w4;
    __syncthreads();
}
__device__ __forceinline__ void tr_tile256(const float* src, int ld, int sc4, bf16_t* dst, int dstK, int n0, int k0, float* tile  ) {
    const int tid = otid(), lane = tid & 63, w = __builtin_amdgcn_readfirstlane(tid >> 6);
    f32x4 v[8];
#pragma unroll
    for (int i = 0; i < 8; ++i) { const int k = i * 8 + w; v[i] = sc4 >= 0 ? *(const f32x4*)(src + (size_t)(k0 + k) * ld + sc4) : (f32x4){0.f, 0.f, 0.f, 0.f}; }
#pragma unroll
    for (int i = 0; i < 8; ++i) { const int k = i * 8 + w; *(f32x4*)(tile + k * 260 + lane * 4) = v[i]; }
    __syncthreads();
    const int nl = (lane & 31) + 32 * w, kq = lane >> 5;
#pragma unroll
    for (int j = 0; j < 4; ++j) { const int k8 = (kq + 2 * j) * 8; float t[8];
#pragma unroll
        for (int i = 0; i < 8; ++i) t[i] = tile[(k8 + i) * 260 + nl];
        u32x4 w4; w4.x = cvtpk(t[0], t[1]); w4.y = cvtpk(t[2], t[3]); w4.z = cvtpk(t[4], t[5]); w4.w = cvtpk(t[6], t[7]);
        *(u32x4*)(dst + (size_t)(n0 + nl) * dstK + k0 + k8) = w4; }
    __syncthreads();
}
__device__ __forceinline__ int win_col(int n) {
    const int c = n >> 7, r = n & 127;
    if (c < 24) return n;
    if (c < 44) return 3088 + (c - 24) * 128 + r;
    if (c == 44) { if (r < 16) return 3072 + r; if (r < 40) return 5648 + (r - 16); }
    return -1;
}
__constant__ float ROPE_INV[16] = {1.000000000e+00f, 4.403665960e-01f, 1.939227432e-01f, 8.539710194e-02f, 3.760603070e-02f, 1.656043902e-02f, 7.292664610e-03f, 3.211445874e-03f,
                                   1.414213562e-03f, 6.227723788e-04f, 2.742481884e-04f, 1.207697351e-04f, 5.318296098e-05f, 2.341999971e-05f, 1.031338616e-05f, 4.541670478e-06f};

__device__ void transpose_w13(const Params& p, float* tile) {
    bf16_t* dst = (bf16_t*)(p.ws + WS_W13T);
    const int lane = otid() & 63;
    for (int it = blockIdx.x; it < 44 * 32; it += gridDim.x) { const int pn = it >> 5, kt = it & 31;
        const int which = lane >> 5, j0 = pn * 128 + (lane & 31) * 4;
        tr_tile256(which ? p.ffn_w3 : p.ffn_w1, FFH, j0, dst, DM, pn * 256, kt * 64, tile); }
}
__device__ void transpose_w2(const Params& p, float* tile) {
    bf16_t* dst = (bf16_t*)(p.ws + WS_W2T);
    const int lane = otid() & 63;
    for (int it = blockIdx.x; it < 8 * 88; it += gridDim.x) { const int nt = it / 88, kt = it % 88;
        tr_tile256(p.ffn_w2, DM, nt * 256 + lane * 4, dst, FFH, nt * 256, kt * 64, tile); }
}

__device__ void phase_convert(const Params& p, unsigned char* lds) {
    float* tile = (float*)lds;
    const int tid = otid(), lane = tid & 63;
    { const f32x4* xs = (const f32x4*)p.x; u32x2* xd = (u32x2*)(p.ws + WS_XB);
      for (size_t i = (size_t)blockIdx.x * 512 + tid; i < (size_t)NTOK * DM / 4; i += (size_t)gridDim.x * 512) { const f32x4 v = xs[i]; u32x2 w; w.x = cvtpk(v[0], v[1]); w.y = cvtpk(v[2], v[3]); xd[i] = w; } }
    { bf16_t* dst = (bf16_t*)(p.ws + WS_WINT);
      for (int it = blockIdx.x; it < 23 * 32; it += gridDim.x) { const int nt = it >> 5, kt = it & 31; tr_tile256(p.w_in, INW, win_col(nt * 256 + lane * 4), dst, DM, nt * 256, kt * 64, tile); } }
    { bf16_t* dst = (bf16_t*)(p.ws + WS_WOUTT);
      for (int it = blockIdx.x; it < 8 * 32; it += gridDim.x) { const int nt = it >> 5, kt = it & 31; tr_tile256(p.w_out, DM, nt * 256 + lane * 4, dst, DM, nt * 256, kt * 64, tile); } }
    for (int kv = 0; kv < 2; ++kv) {
        const float* w1 = kv ? p.cv_w1 : p.ck_w1; const float* w2 = kv ? p.cv_w2 : p.ck_w2;
        bf16_t* d1 = (bf16_t*)(p.ws + WS_CW1T) + (size_t)kv * 256 * 4096; bf16_t* d2 = (bf16_t*)(p.ws + WS_CW2T) + (size_t)kv * 128 * 256;
        for (int it = blockIdx.x; it < 64; it += gridDim.x) { tr_tile256(w1, 256, lane * 4, d1, 4096, 0, it * 64, tile); }
        for (int it = blockIdx.x; it < 2 * 4; it += gridDim.x) { const int nt = it >> 2, kt = it & 3; tr_tile(w2, 128, nt * 64 + lane, d2, 256, nt * 64, kt * 64, tile); }
    }
    for (int it = blockIdx.x; it < 32; it += gridDim.x) {
        const int kv = it >> 4, part = it & 15; const float* w1 = kv ? p.cv_w1 : p.ck_w1; const float* pos = kv ? p.cv_pos : p.ck_pos;
        const int j = tid & 255, half = tid >> 8; float s = 0.f;
        for (int i = 0; i < 128; ++i) { const int row = part * 256 + half * 128 + i; s += pos[row] * w1[(size_t)row * 256 + j]; }
        __syncthreads(); tile[tid] = s; __syncthreads();
        if (tid < 256) ((float*)(p.ws + WS_C1P))[(kv * 16 + part) * 256 + j] = tile[tid] + tile[tid + 256];
        __syncthreads();
    }
    { float* rc = (float*)(p.ws + WS_ROPE); float* rs = rc + 2048 * 16;
      for (int i = blockIdx.x * 512 + tid; i < 2048 * 16; i += gridDim.x * 512) { const int pos = i >> 4, k = i & 15;
          const float ang = (float)pos * ROPE_INV[k]; const double rev = (double)ang * 0.15915494309189535; const float fr = (float)(rev - rint(rev));
          rc[i] = __builtin_amdgcn_cosf(fr); rs[i] = __builtin_amdgcn_sinf(fr); } }
}

__device__ void phase_rope(const Params& p) {
    const float* rc = (const float*)(p.ws + WS_ROPE); const float* rs = rc + 2048 * 16;
    for (int idx = blockIdx.x * 512 + otid(); idx < 12 * NTOK; idx += gridDim.x * 512) {
        const int kind = idx / NTOK, tok = idx - kind * NTOK, pos = tok & (SEQ - 1);
        const bf16_t* src; bf16_t* dst;
        if (kind < 8) { src = uchunk(p, 24 + kind) + (size_t)tok * 128; dst = (bf16_t*)(p.ws + WS_QR) + ((size_t)kind * NTOK + tok) * 128; }
        else { const int c = kind < 10 ? 36 + (kind - 8) : 40 + (kind - 10); dst = uchunk(p, c) + (size_t)tok * 128; src = dst; }
        u32x4 a0 = ((const u32x4*)src)[0], a1 = ((const u32x4*)src)[1], b0 = ((const u32x4*)src)[2], b1 = ((const u32x4*)src)[3];
        unsigned xa[8] = {a0.x, a0.y, a0.z, a0.w, a1.x, a1.y, a1.z, a1.w}, xb[8] = {b0.x, b0.y, b0.z, b0.w, b1.x, b1.y, b1.z, b1.w};
        unsigned oa[8], ob[8];
#pragma unroll
        for (int i = 0; i < 8; ++i) {
            const float c0 = rc[pos * 16 + 2 * i], c1 = rc[pos * 16 + 2 * i + 1], s0 = rs[pos * 16 + 2 * i], s1 = rs[pos * 16 + 2 * i + 1];
            const float x10 = bflo(xa[i]), x11 = bfhi(xa[i]), x20 = bflo(xb[i]), x21 = bfhi(xb[i]);
            oa[i] = cvtpk(x10 * c0 - x20 * s0, x11 * c1 - x21 * s1);
            ob[i] = cvtpk(x20 * c0 + x10 * s0, x21 * c1 + x11 * s1);
        }
        ((u32x4*)dst)[0] = (u32x4){oa[0], oa[1], oa[2], oa[3]}; ((u32x4*)dst)[1] = (u32x4){oa[4], oa[5], oa[6], oa[7]};
        ((u32x4*)dst)[2] = (u32x4){ob[0], ob[1], ob[2], ob[3]}; ((u32x4*)dst)[3] = (u32x4){ob[4], ob[5], ob[6], ob[7]};
        if (kind < 8) {
#pragma unroll
            for (int i = 4; i < 16; ++i) ((u32x4*)dst)[i] = ((const u32x4*)src)[i];
        }
    }
}

__device__ __forceinline__ void gla_bc(const Params& p, int b, int h, int n, float* glr  , float* tot  , float (&bc)[16], float& blast) {
    const int tid = otid(), d = tid & 127, tq = tid >> 7;
    const size_t tok0 = (size_t)b * SEQ + n * 64;
    const bf16_t* u44 = uchunk(p, 44);
    __syncthreads();
    for (int i = tid; i < 1024; i += 512) glr[i] = bf2f(u44[(tok0 + (i >> 4)) * 128 + (i & 15)]);
    float w2[16];
#pragma unroll
    for (int r = 0; r < 16; ++r) w2[r] = p.gate_w2[r * 512 + h * 128 + d];
    const float bias = p.gate_b2[h * 128 + d];
    __syncthreads();
    float run = 0.f;
#pragma unroll
    for (int tt = 0; tt < 16; ++tt) { const int t = tq * 16 + tt; float z = bias;
#pragma unroll
        for (int r = 0; r < 16; ++r) z += glr[t * 16 + r] * w2[r];
        const float ls = fminf(z, 0.f) - log1pf(__expf(-fabsf(z)));
        run += ls * (1.0f / 16.0f); bc[tt] = run; }
    tot[tq * 128 + d] = run;
    __syncthreads();
    float off = 0.f, all = 0.f;
#pragma unroll
    for (int q = 0; q < 4; ++q) { const float v = tot[q * 128 + d]; all += v; if (q < tq) off += v; }
#pragma unroll
    for (int tt = 0; tt < 16; ++tt) bc[tt] += off;
    blast = all;
}
__device__ __forceinline__ void gla_stage_vT(const Params& p, int h, size_t tok0, bf16_t* vT) {
    const int tid = otid();
    for (int pc = tid; pc < 2048; pc += 512) { const int t = pc >> 5, e8 = (pc & 31) * 8;
        const bf16_t* src = uchunk(p, 8 + 2 * h + (e8 >> 7)) + (tok0 + t) * 128 + (e8 & 127);
        const u32x4 w = *(const u32x4*)src; const unsigned ww[4] = {w.x, w.y, w.z, w.w};
#pragma unroll
        for (int i = 0; i < 4; ++i) { vT[(e8 + 2 * i) * 72 + t] = (bf16_t)(ww[i] & 0xffffu); vT[(e8 + 2 * i + 1) * 72 + t] = (bf16_t)(ww[i] >> 16); } }
}
__device__ void gla_g1(const Params& p, int item, unsigned char* lds) {
    const int bh = item >> 5, n = item & 31, b = bh >> 2, h = bh & 3;
    const int tid = otid(), d = tid & 127, tq = tid >> 7, wid = __builtin_amdgcn_readfirstlane(tid >> 6), lane = tid & 63, r32 = lane & 31, hi = lane >> 5;
    float* glr = (float*)lds; float* tot = (float*)(lds + 4096);
    bf16_t* ksT = (bf16_t*)(lds + 8192); bf16_t* vT = (bf16_t*)(lds + 8192 + 128 * 72 * 2);
    const size_t tok0 = (size_t)b * SEQ + n * 64;
    float bc[16], blast; gla_bc(p, b, h, n, glr, tot, bc, blast);
    const bf16_t* kc = uchunk(p, 4 + h);
#pragma unroll
    for (int tt = 0; tt < 16; ++tt) { const int t = tq * 16 + tt; const float kv = bf2f(kc[(tok0 + t) * 128 + d]); ksT[d * 72 + t] = f2bf(kv * __expf(blast - bc[tt])); }
    if (tq == 0) ((float*)(p.ws + WS_DECAY))[(size_t)item * 128 + d] = __expf(blast);
    gla_stage_vT(p, h, tok0, vT);
    __syncthreads();
    f32x16 acc[4] = {};
#pragma unroll
    for (int ks = 0; ks < 4; ++ks) { const bf16x8 a = *(const bf16x8*)(vT + (wid * 32 + r32) * 72 + ks * 16 + hi * 8);
#pragma unroll
        for (int db = 0; db < 4; ++db) { const bf16x8 bb = *(const bf16x8*)(ksT + (db * 32 + r32) * 72 + ks * 16 + hi * 8); acc[db] = MFMA32(a, bb, acc[db]); } }
    bf16_t* ds = (bf16_t*)(p.ws + WS_DS) + (size_t)item * 256 * 128;
#pragma unroll
    for (int db = 0; db < 4; ++db)
#pragma unroll
        for (int r = 0; r < 16; ++r) ds[(wid * 32 + crow(r, hi)) * 128 + db * 32 + r32] = f2bf(acc[db][r]);
}
__device__ void phase_gla_scan(const Params& p) {
    bf16_t* ds = (bf16_t*)(p.ws + WS_DS); const float* dec = (const float*)(p.ws + WS_DECAY);
    for (int idx = blockIdx.x * 512 + otid(); idx < 16 * 256 * 16; idx += gridDim.x * 512) {
        const int bh = idx >> 12, e = (idx >> 4) & 255, d8 = (idx & 15) * 8;
        float st[8] = {0.f, 0.f, 0.f, 0.f, 0.f, 0.f, 0.f, 0.f};
#pragma unroll 4
        for (int n = 0; n < 32; ++n) {
            u32x4* ptr = (u32x4*)(ds + ((size_t)(bh * 32 + n) * 256 + e) * 128 + d8);
            const u32x4 w = *ptr; const f32x4 dc0 = *(const f32x4*)(dec + (size_t)(bh * 32 + n) * 128 + d8), dc1 = *(const f32x4*)(dec + (size_t)(bh * 32 + n) * 128 + d8 + 4);
            u32x4 o; o.x = cvtpk(st[0], st[1]); o.y = cvtpk(st[2], st[3]); o.z = cvtpk(st[4], st[5]); o.w = cvtpk(st[6], st[7]);
            *ptr = o;
            st[0] = dc0[0] * st[0] + bflo(w.x); st[1] = dc0[1] * st[1] + bfhi(w.x); st[2] = dc0[2] * st[2] + bflo(w.y); st[3] = dc0[3] * st[3] + bfhi(w.y);
            st[4] = dc1[0] * st[4] + bflo(w.z); st[5] = dc1[1] * st[5] + bfhi(w.z); st[6] = dc1[2] * st[6] + bflo(w.w); st[7] = dc1[3] * st[7] + bfhi(w.w);
        }
    }
}
__device__ void gla_g3(const Params& p, int item, unsigned char* lds) {
    const int bh = item >> 5, n = item & 31, b = bh >> 2, h = bh & 3;
    const int tid = otid(), d = tid & 127, tq = tid >> 7, wid = __builtin_amdgcn_readfirstlane(tid >> 6), lane = tid & 63, r32 = lane & 31, hi = lane >> 5;
    float* glr = (float*)lds; float* tot = (float*)(lds + 4096);
    bf16_t* qd = (bf16_t*)(lds + 8192); bf16_t* ki = (bf16_t*)(lds + 25600); bf16_t* vT = (bf16_t*)(lds + 43008); bf16_t* at = (bf16_t*)(lds + 79872);
    float* ol = (float*)(lds + 8192);
    const size_t tok0 = (size_t)b * SEQ + n * 64;
    float bc[16], blast; gla_bc(p, b, h, n, glr, tot, bc, blast);
    const bf16_t* qc = uchunk(p, h); const bf16_t* kc = uchunk(p, 4 + h);
#pragma unroll
    for (int tt = 0; tt < 16; ++tt) { const int t = tq * 16 + tt; const float e = __expf(bc[tt]);
        qd[t * 136 + d] = f2bf(bf2f(qc[(tok0 + t) * 128 + d]) * 0.08838834764831845f * e);
        ki[t * 136 + d] = f2bf(bf2f(kc[(tok0 + t) * 128 + d]) / e); }
    gla_stage_vT(p, h, tok0, vT);
    __syncthreads();
    const int ib = wid & 1, eb = (wid >> 1) * 2;
    f32x16 acc[2] = {};
    { const bf16_t* sp = (const bf16_t*)(p.ws + WS_DS) + (size_t)item * 256 * 128;
#pragma unroll
      for (int ks = 0; ks < 8; ++ks) { const bf16x8 a = *(const bf16x8*)(qd + (ib * 32 + r32) * 136 + ks * 16 + hi * 8);
#pragma unroll
          for (int x = 0; x < 2; ++x) { const bf16x8 bb = *(const bf16x8*)(sp + ((eb + x) * 32 + r32) * 128 + ks * 16 + hi * 8); acc[x] = MFMA32(a, bb, acc[x]); } } }
    if (wid < 4) { const int jb = wid >> 1; f32x16 s = {};
#pragma unroll
        for (int ks = 0; ks < 8; ++ks) { const bf16x8 a = *(const bf16x8*)(qd + (ib * 32 + r32) * 136 + ks * 16 + hi * 8); const bf16x8 bb = *(const bf16x8*)(ki + (jb * 32 + r32) * 136 + ks * 16 + hi * 8); s = MFMA32(a, bb, s); }
#pragma unroll
        for (int r = 0; r < 16; ++r) { const int i = ib * 32 + crow(r, hi), j = jb * 32 + r32; at[i * 72 + j] = f2bf(j <= i ? s[r] : 0.f); } }
    __syncthreads();
#pragma unroll
    for (int ks = 0; ks < 4; ++ks) { const bf16x8 a = *(const bf16x8*)(at + (ib * 32 + r32) * 72 + ks * 16 + hi * 8);
#pragma unroll
        for (int x = 0; x < 2; ++x) { const bf16x8 bb = *(const bf16x8*)(vT + ((eb + x) * 32 + r32) * 72 + ks * 16 + hi * 8); acc[x] = MFMA32(a, bb, acc[x]); } }
    __syncthreads();
#pragma unroll
    for (int x = 0; x < 2; ++x)
#pragma unroll
        for (int r = 0; r < 16; ++r) ol[(ib * 32 + crow(r, hi)) * 256 + (eb + x) * 32 + r32] = acc[x][r];
    __syncthreads();
    { const int row = tid >> 3, seg = tid & 7; const float* orow = ol + row * 256 + seg * 32; float ss = 0.f;
#pragma unroll
      for (int i = 0; i < 32; ++i) ss += orow[i] * orow[i];
      ss += __shfl_xor(ss, 1); ss += __shfl_xor(ss, 2); ss += __shfl_xor(ss, 4);
      const float rstd = rsqrtf(ss * (1.0f / 256.0f) + LN_EPS);
      const int e0 = seg * 32; const bf16_t* go = uchunk(p, 16 + 2 * h + (e0 >> 7)) + (tok0 + row) * 128 + (e0 & 127);
      bf16_t* dst = (bf16_t*)(p.ws + WS_A) + (tok0 + row) * DM + h * 256 + e0;
#pragma unroll
      for (int c = 0; c < 4; ++c) { const u32x4 g = ((const u32x4*)go)[c]; const unsigned gw[4] = {g.x, g.y, g.z, g.w}; unsigned ow[4];
#pragma unroll
          for (int i = 0; i < 4; ++i) { const int e = c * 8 + 2 * i; const float g0 = bflo(gw[i]), g1 = bfhi(gw[i]);
              const float v0 = orow[e] * rstd * p.norm_w[e0 + e] * g0 / (1.0f + __expf(-g0)), v1 = orow[e + 1] * rstd * p.norm_w[e0 + e + 1] * g1 / (1.0f + __expf(-g1));
              ow[i] = cvtpk(v0, v1); }
          ((u32x4*)dst)[c] = (u32x4){ow[0], ow[1], ow[2], ow[3]}; } }
    __syncthreads();
}

__device__ void compress_item(const Params& p, int item, unsigned char* lds) {
    const int kv = item >> 5, g = (item >> 4) & 1, rt = item & 15;
    const int tid = otid(), wid = __builtin_amdgcn_readfirstlane(tid >> 6), lane = tid & 63, r32 = lane & 31, hi = lane >> 5;
    const int ksl = wid >> 1, nh = wid & 1;
    const bf16_t* A = uchunk(p, 32 + 2 * kv + g) + (size_t)(rt * 32 + r32) * 2048 + ksl * 1024 + hi * 8;
    const bf16_t* W = (const bf16_t*)(p.ws + WS_CW1T) + (size_t)kv * 256 * 4096 + (size_t)(nh * 128 + r32) * 4096 + ksl * 1024 + hi * 8;
    f32x16 acc[4] = {};
#pragma unroll 2
    for (int ks = 0; ks < 64; ++ks) { const bf16x8 a = *(const bf16x8*)(A + ks * 16);
#pragma unroll
        for (int nb = 0; nb < 4; ++nb) { const bf16x8 bb = *(const bf16x8*)(W + (size_t)nb * 32 * 4096 + ks * 16); acc[nb] = MFMA32(a, bb, acc[nb]); } }
    float* hid = (float*)lds;
    bf16_t* hb = (bf16_t*)(lds + 32768);
    __syncthreads();
    for (int s = 0; s < 4; ++s) {
        if (ksl == s) {
#pragma unroll
            for (int nb = 0; nb < 4; ++nb)
#pragma unroll
                for (int r = 0; r < 16; ++r) { float* q = hid + crow(r, hi) * 256 + nh * 128 + nb * 32 + r32; *q = (s == 0 ? 0.f : *q) + acc[nb][r]; } }
        __syncthreads();
    }
    { const float* c1p = (const float*)(p.ws + WS_C1P) + kv * 16 * 256;
      for (int i = tid; i < 32 * 256; i += 512) { const int j = i & 255; float v = hid[i];
#pragma unroll
          for (int q = 0; q < 16; ++q) v += c1p[q * 256 + j];
          const float u = 0.7978845608028654f * (v + 0.044715f * v * v * v); const float th = 1.0f - 2.0f / (__expf(2.0f * u) + 1.0f);
          hb[(i >> 8) * 264 + j] = f2bf(0.5f * v * (1.0f + th)); } }
    __syncthreads();
    if (wid < 4) { const bf16_t* W2 = (const bf16_t*)(p.ws + WS_CW2T) + (size_t)kv * 128 * 256 + (size_t)(wid * 32 + r32) * 256 + hi * 8; f32x16 o = {};
#pragma unroll
        for (int ks = 0; ks < 16; ++ks) { const bf16x8 a = *(const bf16x8*)(hb + r32 * 264 + ks * 16 + hi * 8); const bf16x8 bb = *(const bf16x8*)(W2 + ks * 16); o = MFMA32(a, bb, o); }
        bf16_t* dst = (bf16_t*)(p.ws + WS_KCMP) + (size_t)kv * 4 * 2 * 128 * 128;
#pragma unroll
        for (int r = 0; r < 16; ++r) { const int m = rt * 32 + crow(r, hi), bb_ = m >> 7, nn = m & 127; dst[((size_t)(bb_ * 2 + g) * 128 + nn) * 128 + wid * 32 + r32] = nn == 127 ? (bf16_t)0 : f2bf(o[r]); } }
    __syncthreads();
}

constexpr int SHM_K = 16384, SHM_V = 16384;
constexpr float SCALE = 0.08838834764831845f;
constexpr float THR = 8.f;
#define KSWZ(row, colB) ((row) * 256 + ((colB) ^ (((row) & 7) << 4)))
#define SBAR() __builtin_amdgcn_sched_barrier(0)
__device__ __forceinline__ int v_st(int k, int c) { const int kk = (k & ~0xC) | ((k & 4) << 1) | ((k & 8) >> 1); return ((kk >> 3) * 4 + (c >> 5)) * 512 + ((kk & 7) * 32 + (c & 31)) * 2; }
__device__ __forceinline__ int v_rd_base(int lane) { return ((lane & 3) << 3) | (((lane >> 2) & 3) << 6) | (((lane >> 4) & 1) << 5) | (((lane >> 5) & 1) << 8); }
constexpr int v_rd_off(int d0, int ks, int half) { return d0 * 512 + ks * 4096 + half * 2048; }
__device__ __forceinline__ void mask_tile(f32x16& p0, f32x16& p1, int dq, unsigned W) {
    const float NEG = -__builtin_inff();
#pragma unroll
    for (int r = 0; r < 16; ++r) { const int c = (r & 3) + 8 * (r >> 2);
        if ((unsigned)(dq - c) >= W) p0[r] = NEG;
        if ((unsigned)(dq - c - 32) >= W) p1[r] = NEG; }
}
__device__ __forceinline__ void partialSM(f32x16& p0, f32x16& p1, float& m_reg, float& mn, float& alpha) {
    float pmax = p0[0];
#pragma unroll
    for (int r = 1; r < 16; ++r) pmax = fmaxf(pmax, p0[r]);
#pragma unroll
    for (int r = 0; r < 16; ++r) pmax = fmaxf(pmax, p1[r]);
    { auto rr = __builtin_amdgcn_permlane32_swap(__float_as_uint(pmax), __float_as_uint(pmax), false, false);
      pmax = fmaxf(__uint_as_float(rr[0]), __uint_as_float(rr[1])); }
    constexpr float C2 = 1.4426950408889634f * SCALE;
    if (__builtin_expect(__all((pmax - m_reg) * SCALE <= THR), 1)) { mn = m_reg; alpha = 1.f; }
    else { mn = fmaxf(m_reg, pmax); alpha = __builtin_amdgcn_exp2f((m_reg - mn) * C2); m_reg = mn; }
    const float mnL = -mn * C2;
#pragma unroll
    for (int r = 0; r < 16; ++r) p0[r] = fmaf(p0[r], C2, mnL);
#pragma unroll
    for (int r = 0; r < 16; ++r) p1[r] = fmaf(p1[r], C2, mnL);
#pragma unroll
    for (int r = 0; r < 16; ++r) p0[r] = __builtin_amdgcn_exp2f(p0[r]);
}
#define PK4(P, B_, OUT) do { unsigned a0 = cvtpk(P[B_+0], P[B_+1]), a1 = cvtpk(P[B_+2], P[B_+3]);                          \
        unsigned b0 = cvtpk(P[B_+4], P[B_+5]), b1 = cvtpk(P[B_+6], P[B_+7]);                                             \
        auto r0 = __builtin_amdgcn_permlane32_swap(a0, b0, false, false); auto r1 = __builtin_amdgcn_permlane32_swap(a1, b1, false, false); \
        u32x4 w = {r0[0], r1[0], r0[1], r1[1]}; OUT = *reinterpret_cast<bf16x8*>(&w); } while (0)
__device__ __forceinline__ void pack_p(const f32x16& p0, const f32x16& p1, bf16x8& pa0, bf16x8& pa1, bf16x8& pa2, bf16x8& pa3) {
    PK4(p0, 0, pa0); PK4(p0, 8, pa1); PK4(p1, 0, pa2); PK4(p1, 8, pa3);
}
__device__ __forceinline__ void finishSM(f32x16& p0, f32x16& p1, float alpha, float& l_reg, bf16x8& pa0, bf16x8& pa1, bf16x8& pa2, bf16x8& pa3) {
#pragma unroll
    for (int r = 0; r < 16; ++r) p1[r] = __builtin_amdgcn_exp2f(p1[r]);
    float ps = 0;
#pragma unroll
    for (int r = 0; r < 16; ++r) ps += p0[r];
#pragma unroll
    for (int r = 0; r < 16; ++r) ps += p1[r];
    { auto rr = __builtin_amdgcn_permlane32_swap(__float_as_uint(ps), __float_as_uint(ps), false, false);
      ps = __uint_as_float(rr[0]) + __uint_as_float(rr[1]); }
    l_reg = l_reg * alpha + ps;
    pack_p(p0, p1, pa0, pa1, pa2, pa3);
}
template <int KB>
__device__ __forceinline__ void qkt(f32x16& p0, f32x16& p1, const char* K_lds, int r32, int hi, const bf16x8* qr) {
    p0 = f32x16{}; p1 = f32x16{};
    const char* kb[4];
#pragma unroll
    for (int dd = 0; dd < 4; ++dd) kb[dd] = K_lds + KB * SHM_K + KSWZ(r32, (dd * 16 + hi * 8) * 2);
#pragma unroll
    for (int d0 = 0; d0 < 8; ++d0) { const char* a = kb[d0 & 3] + (d0 >> 2) * 128;
        bf16x8 b0 = *reinterpret_cast<const bf16x8*>(a);
        bf16x8 b1 = *reinterpret_cast<const bf16x8*>(a + 32 * 256);
        p0 = MFMA32(b0, qr[d0], p0);
        p1 = MFMA32(b1, qr[d0], p1); }
}
template <int VB>
__device__ __forceinline__ void pv_tile(f32x16* o, int vb0, bf16x8 pa0, bf16x8 pa1, bf16x8 pa2, bf16x8 pa3) {
#define TRRD(dst, off) asm volatile("ds_read_b64_tr_b16 %0, %1 offset:%2" : "=&v"(dst) : "v"(vb0), "i"(off) : "memory")
#define PV_D0(d0) do { s16x4 l0, l1, l2, l3, h0, h1, h2, h3; constexpr int b_ = VB * SHM_V + v_rd_off(d0, 0, 0); \
        TRRD(l0, b_); TRRD(h0, b_ + 2048); TRRD(l1, b_ + 4096); TRRD(h1, b_ + 6144); TRRD(l2, b_ + 8192); TRRD(h2, b_ + 10240); TRRD(l3, b_ + 12288); TRRD(h3, b_ + 14336); \
        asm volatile("s_waitcnt lgkmcnt(0)" ::: "memory"); SBAR(); \
        o[d0] = MFMA32(pa0, ((bf16x8){l0[0], l0[1], l0[2], l0[3], h0[0], h0[1], h0[2], h0[3]}), o[d0]);   \
        o[d0] = MFMA32(pa1, ((bf16x8){l1[0], l1[1], l1[2], l1[3], h1[0], h1[1], h1[2], h1[3]}), o[d0]);   \
        o[d0] = MFMA32(pa2, ((bf16x8){l2[0], l2[1], l2[2], l2[3], h2[0], h2[1], h2[2], h2[3]}), o[d0]);   \
        o[d0] = MFMA32(pa3, ((bf16x8){l3[0], l3[1], l3[2], l3[3], h3[0], h3[1], h3[2], h3[3]}), o[d0]); } while (0)
    PV_D0(0); PV_D0(1); PV_D0(2); PV_D0(3);
#undef PV_D0
#undef TRRD
}
__device__ __forceinline__ void stage_kv(const bf16_t* Kg, const bf16_t* Vg, char* K_lds, char* V_lds, int bf) {
    const int tid = otid(), sr = tid >> 4, sc = (tid & 15) * 8;
    const bf16x8 k0 = *(const bf16x8*)(Kg + (size_t)sr * 128 + sc), k1 = *(const bf16x8*)(Kg + (size_t)(32 + sr) * 128 + sc);
    const bf16x8 v0 = *(const bf16x8*)(Vg + (size_t)sr * 128 + sc), v1 = *(const bf16x8*)(Vg + (size_t)(32 + sr) * 128 + sc);
    *(bf16x8*)(K_lds + bf * SHM_K + KSWZ(sr, sc * 2)) = k0; *(bf16x8*)(K_lds + bf * SHM_K + KSWZ(sr, sc * 2) + 32 * 256) = k1;
    *(bf16x8*)(V_lds + bf * SHM_V + v_st(sr, sc)) = v0; *(bf16x8*)(V_lds + bf * SHM_V + v_st(32 + sr, sc)) = v1;
}

__device__ void cmp_item(const Params& p, int item, unsigned char* ldsu) {
    char* lds = (char*)ldsu;
    const int b = item >> 6, g = (item >> 5) & 1, tt = item & 31;
    const int tid = otid(), wid = __builtin_amdgcn_readfirstlane(tid >> 6), lane = tid & 63, r32 = lane & 31, hi = lane >> 5;
    const int hh = wid & 3, sb = wid >> 2, head = g * 4 + hh, t = tt * 64 + sb * 32 + r32;
    const size_t tok = (size_t)b * SEQ + t;
    char* V_lds = lds; char* K_lds = lds + 2 * SHM_V;
    float* wsf = (float*)(lds + 2 * SHM_V + 2 * SHM_K) + wid * 64;
    float* impw = (float*)(lds + 67584); float* imps = (float*)(lds + 67584 + 32768);
    const bf16_t* kc = (const bf16_t*)(p.ws + WS_KCMP) + (size_t)((0 * 4 + b) * 2 + g) * 128 * 128;
    const bf16_t* vc = (const bf16_t*)(p.ws + WS_KCMP) + (size_t)((1 * 4 + b) * 2 + g) * 128 * 128;
    __syncthreads();
    stage_kv(kc, vc, K_lds, V_lds, 0); stage_kv(kc + 64 * 128, vc + 64 * 128, K_lds, V_lds, 1);
    bf16x8 qr[8];
    { const bf16_t* Q = uchunk(p, 24 + head) + tok * 128;
#pragma unroll
      for (int d0 = 0; d0 < 8; ++d0) qr[d0] = *(const bf16x8*)(Q + d0 * 16 + hi * 8); }
    __syncthreads();
    const int nmax = (t - 31) >> 4; const float NEG = -__builtin_inff();
    constexpr float C2 = 1.4426950408889634f * SCALE;
    float* invw = (float*)(lds + 67584 + 32768 + 8192);
    float mx = NEG;
    { f32x16 s0, s1;
      qkt<0>(s0, s1, K_lds, r32, hi, qr);
#pragma unroll
      for (int r = 0; r < 16; ++r) { const int key = (r & 3) + 8 * (r >> 2) + 4 * hi; mx = fmaxf(mx, key <= nmax ? s0[r] : NEG); mx = fmaxf(mx, key + 32 <= nmax ? s1[r] : NEG); }
      SBAR(); qkt<1>(s0, s1, K_lds, r32, hi, qr);
#pragma unroll
      for (int r = 0; r < 16; ++r) { const int key = 64 + (r & 3) + 8 * (r >> 2) + 4 * hi; mx = fmaxf(mx, key <= nmax ? s0[r] : NEG); mx = fmaxf(mx, key + 32 <= nmax ? s1[r] : NEG); } }
    { auto rr = __builtin_amdgcn_permlane32_swap(__float_as_uint(mx), __float_as_uint(mx), false, false); mx = fmaxf(__uint_as_float(rr[0]), __uint_as_float(rr[1])); }
    const float mref = (mx == NEG) ? 0.f : mx, mnL = -mref * C2;
    float sum = 0.f, plPrev = 0.f;
    f32x16 o[4] = {};
    const int vb0 = (int)(uintptr_t)V_lds + v_rd_base(lane);
#define IMP_SRC(P, base) _Pragma("unroll") for (int q = 0; q < 4; ++q) { const float Gq = (P[4 * q] + P[4 * q + 1]) + (P[4 * q + 2] + P[4 * q + 3]); const float pl = __shfl_xor(P[4 * q + 3], 32); \
          impw[(wid * 32 + r32) * 32 + 2 * ((base) + q) + hi] = Gq + (hi ? pl : plPrev); plPrev = pl; }
#define CMP_TILE(TB) do { f32x16 p0, p1; bf16x8 pa0, pa1, pa2, pa3; qkt<TB>(p0, p1, K_lds, r32, hi, qr); \
      _Pragma("unroll") for (int r = 0; r < 16; ++r) { const int key = TB * 64 + (r & 3) + 8 * (r >> 2) + 4 * hi; \
          p0[r] = key <= nmax ? __builtin_amdgcn_exp2f(fmaf(p0[r], C2, mnL)) : 0.f; p1[r] = key + 32 <= nmax ? __builtin_amdgcn_exp2f(fmaf(p1[r], C2, mnL)) : 0.f; sum += p0[r] + p1[r]; } \
      SBAR(); IMP_SRC(p0, TB * 8) IMP_SRC(p1, TB * 8 + 4) SBAR(); \
      pack_p(p0, p1, pa0, pa1, pa2, pa3); pv_tile<TB>(o, vb0, pa0, pa1, pa2, pa3); } while (0)
    SBAR(); CMP_TILE(0); SBAR(); CMP_TILE(1); SBAR();
#undef CMP_TILE
#undef IMP_SRC
    { auto rr = __builtin_amdgcn_permlane32_swap(__float_as_uint(sum), __float_as_uint(sum), false, false); sum = __uint_as_float(rr[0]) + __uint_as_float(rr[1]); }
    const float inv = sum > 0.f ? 1.0f / sum : 0.f;
    if (hi == 0) { wsf[r32] = inv * sigmoidf_(bf2f(uchunk(p, 44)[tok * 128 + 16 + head * 3 + 0])); invw[wid * 32 + r32] = inv; }

    asm volatile("s_waitcnt lgkmcnt(0)" ::: "memory");
    { bf16_t* O = (bf16_t*)(p.ws + WS_OP) + ((size_t)b * SEQ + tt * 64 + sb * 32) * 1024 + head * 128;
#pragma unroll
      for (int r = 0; r < 16; ++r) { const int orow = crow(r, hi); const float gt = wsf[orow];
#pragma unroll
          for (int d0 = 0; d0 < 4; ++d0) O[(size_t)orow * 1024 + d0 * 32 + r32] = f2bf(o[d0][r] * gt); } }
    __syncthreads();
    { const int tokl = tid >> 3, jq = tid & 7, tpos = tt * 64 + tokl, cur = tpos >> 6, sbt = tokl >> 5, rr_ = tokl & 31;
#pragma unroll
      for (int jj = 0; jj < 4; ++jj) { const int j = jq * 4 + jj; float v = 0.f;
#pragma unroll
          for (int h4 = 0; h4 < 4; ++h4) v += impw[((sbt * 4 + h4) * 32 + rr_) * 32 + j] * invw[(sbt * 4 + h4) * 32 + rr_];
          if (j > cur) v = -1e4f;
          if (j == 0 || j == cur || j == cur - 1) v = 1e4f;
          imps[tokl * 32 + j] = v; }
      __syncthreads();
      float vi[32];
#pragma unroll
      for (int i = 0; i < 32; ++i) vi[i] = imps[tokl * 32 + i];
      unsigned word = 0;
#pragma unroll
      for (int jj = 0; jj < 4; ++jj) { const int j = jq * 4 + jj; const float vj = imps[tokl * 32 + j]; int cnt = 0;
#pragma unroll
          for (int i = 0; i < 32; ++i) cnt += (vi[i] > vj || (vi[i] == vj && i < j)) ? 1 : 0;
          if (cnt < 16) word |= 1u << j; }
      word |= __shfl_xor(word, 1); word |= __shfl_xor(word, 2); word |= __shfl_xor(word, 4);
      if (jq == 0) ((unsigned*)(p.ws + WS_MASK))[(size_t)(b * 2 + g) * SEQ + tpos] = word; }
    __syncthreads();
}

template <int MODE>
__device__ void attn_block(const Params& p, int b, int head, int qb, unsigned char* ldsu) {
    char* lds = (char*)ldsu;
    const int tid = otid(), wid = __builtin_amdgcn_readfirstlane(tid >> 6), lane = tid & 63, r32 = lane & 31, hi = lane >> 5;
    const int g = head >> 2, P0 = qb * 256, qlo = P0 + wid * 32, qpos = qlo + r32, qm = qpos - 4 * hi;
    const size_t tokb = (size_t)b * SEQ;
    char* V_lds = lds; char* K_lds = lds + 2 * SHM_V;
    float* wsf = (float*)(lds + 2 * SHM_V + 2 * SHM_K) + wid * 64; float* li_l = wsf; float* al_l = wsf + 32;
    const bf16_t* K = uchunk(p, (MODE ? 36 : 40) + g) + tokb * 128; const bf16_t* V = uchunk(p, (MODE ? 38 : 42) + g) + tokb * 128;
    bf16x8 qr[8];
    { const bf16_t* Q = (const bf16_t*)(p.ws + WS_QR) + ((size_t)head * NTOK + tokb + qpos) * 128;
#pragma unroll
      for (int d0 = 0; d0 < 8; ++d0) qr[d0] = *(const bf16x8*)(Q + d0 * 16 + hi * 8); }
    const unsigned msk = MODE ? ((const unsigned*)(p.ws + WS_MASK))[(size_t)(b * 2 + g) * SEQ + qpos] : 0u;
    const int j_lo = MODE ? 0 : ((P0 - 511 > 0 ? P0 - 511 : 0) >> 6), j_hi = qb * 4 + 4;
    float m_reg = -1e30f, l_reg = 0.f; f32x16 o[4] = {};
    const int vb0 = (int)(uintptr_t)V_lds + v_rd_base(lane);
    for (int j = j_lo; j < j_hi; ++j) {
        const int kb = j * 64;
        __syncthreads();
        stage_kv(K + (size_t)kb * 128, V + (size_t)kb * 128, K_lds, V_lds, 0);
        __syncthreads();
        const bool act = MODE ? (kb <= qlo + 31) : (kb <= qlo + 31 && kb + 63 >= qlo - 511);
        if (!act) continue;
        if (MODE) { if (!__any((int)((msk >> j) & 1u))) continue; }
        f32x16 p0, p1; float mn, alpha; bf16x8 pa0, pa1, pa2, pa3;
        qkt<0>(p0, p1, K_lds, r32, hi, qr);
        if (MODE == 0) { if (kb + 63 > qlo || kb <= qlo + 31 - 512) mask_tile(p0, p1, qm - kb, 512u); }
        else { if (kb + 63 > qlo) mask_tile(p0, p1, qm - kb, 0x7fffffffu);
               if (!((msk >> j) & 1u)) { const float NEG = -__builtin_inff();
#pragma unroll
                   for (int r = 0; r < 16; ++r) { p0[r] = NEG; p1[r] = NEG; } } }
        partialSM(p0, p1, m_reg, mn, alpha);
        if (__any(alpha < 1.f)) { if (hi == 0) al_l[r32] = alpha; asm volatile("s_waitcnt lgkmcnt(0)" ::: "memory");
#pragma unroll
            for (int d_ = 0; d_ < 4; ++d_)
#pragma unroll
                for (int r = 0; r < 16; ++r) o[d_][r] *= al_l[crow(r, hi)]; }
        finishSM(p0, p1, alpha, l_reg, pa0, pa1, pa2, pa3);
        pv_tile<0>(o, vb0, pa0, pa1, pa2, pa3);
    }
    if (hi == 0) { li_l[r32] = l_reg; al_l[r32] = sigmoidf_(bf2f(uchunk(p, 44)[(tokb + qpos) * 128 + 16 + head * 3 + (MODE ? 1 : 2)])); }
    asm volatile("s_waitcnt lgkmcnt(0)" ::: "memory");
    { bf16_t* O = (bf16_t*)(p.ws + WS_OP) + (size_t)(MODE ? 1 : 2) * NTOK * 1024 + (tokb + qlo) * 1024 + head * 128;
#pragma unroll
      for (int r = 0; r < 16; ++r) { const int orow = crow(r, hi); const float sc = al_l[orow] / li_l[orow];
#pragma unroll
          for (int d0 = 0; d0 < 4; ++d0) O[(size_t)orow * 1024 + d0 * 32 + r32] = f2bf(o[d0][r] * sc); } }
    __syncthreads();
}

__device__ void phase_combine(const Params& p) {
    const u32x4* o0 = (const u32x4*)(p.ws + WS_OP); const u32x4* o1 = o0 + (size_t)NTOK * 1024 / 8; const u32x4* o2 = o1 + (size_t)NTOK * 1024 / 8;
    bf16_t* A = (bf16_t*)(p.ws + WS_A);
    for (size_t i = (size_t)blockIdx.x * 512 + otid(); i < (size_t)NTOK * 128; i += (size_t)gridDim.x * 512) {
        const size_t tok = i >> 7; const int c8 = (int)(i & 127) * 8;
        const u32x4 a = o0[i], b = o1[i], c = o2[i]; u32x4 w;
        w.x = cvtpk(bflo(a.x) + bflo(b.x) + bflo(c.x), bfhi(a.x) + bfhi(b.x) + bfhi(c.x));
        w.y = cvtpk(bflo(a.y) + bflo(b.y) + bflo(c.y), bfhi(a.y) + bfhi(b.y) + bfhi(c.y));
        w.z = cvtpk(bflo(a.z) + bflo(b.z) + bflo(c.z), bfhi(a.z) + bfhi(b.z) + bfhi(c.z));
        w.w = cvtpk(bflo(a.w) + bflo(b.w) + bflo(c.w), bfhi(a.w) + bfhi(b.w) + bfhi(c.w));
        *(u32x4*)(A + tok * DM + 1024 + c8) = w;
    }
}

template <bool WRITE_BF>
__device__ void phase_ln(const Params& p, const float* gam, const float* bet) {
    const int wid = __builtin_amdgcn_readfirstlane(otid() >> 6), lane = otid() & 63;
    for (int row = blockIdx.x * 8 + wid; row < NTOK; row += gridDim.x * 8) {
        float* rp = p.out + (size_t)row * DM;
        f32x4 v[8]; float s = 0.f;
#pragma unroll
        for (int i = 0; i < 8; ++i) { v[i] = *(const f32x4*)(rp + (i * 64 + lane) * 4); s += (v[i][0] + v[i][1]) + (v[i][2] + v[i][3]); }
#pragma unroll
        for (int o = 32; o >= 1; o >>= 1) s += __shfl_xor(s, o);
        const float mean = s * (1.0f / DM); float q = 0.f;
#pragma unroll
        for (int i = 0; i < 8; ++i) { const f32x4 d = v[i] - mean; q += (d[0] * d[0] + d[1] * d[1]) + (d[2] * d[2] + d[3] * d[3]); }
#pragma unroll
        for (int o = 32; o >= 1; o >>= 1) q += __shfl_xor(q, o);
        const float rstd = rsqrtf(q * (1.0f / DM) + LN_EPS);
#pragma unroll
        for (int i = 0; i < 8; ++i) { const int c = (i * 64 + lane) * 4; const f32x4 gg = *(const f32x4*)(gam + c), bb = *(const f32x4*)(bet + c);
            const f32x4 y = (v[i] - mean) * rstd * gg + bb; *(f32x4*)(rp + c) = y;
            if (WRITE_BF) { u32x2 w; w.x = cvtpk(y[0], y[1]); w.y = cvtpk(y[2], y[3]); *(u32x2*)((bf16_t*)(p.ws + WS_HB) + (size_t)row * DM + c) = w; } }
    }
}

template <class Epi>
__device__ __forceinline__ void run_gemm(unsigned char* shm, const bf16_t* A, const bf16_t* Bt, int M, int N, int K, const Epi& E) {
    pg8::StaticOrder S; S.init(M, N, (int)gridDim.x, (int)blockIdx.x);
    pg8::Gemm g{A, Bt, M, N, K};
    pg8::gemm_phase<Epi, pg8::StaticOrder, false>((PG8_LAS unsigned char*)shm, g, S, E, nullptr);
    __syncthreads();
}
__device__ void phase_p2(const Params& p, unsigned char* shm, bool rope = true) {
    if (rope) phase_rope(p);
    const int G = gridDim.x, w = blockIdx.x;
    if (G > 64) { if (w < 64) compress_item(p, w, shm); else for (int i = w - 64; i < 512; i += G - 64) gla_g1(p, i, shm); }
    else { for (int i = w; i < 64; i += G) compress_item(p, i, shm); for (int i = w; i < 512; i += G) gla_g1(p, i, shm); }
}
__device__ __forceinline__ bool p4_decode(int i, int& mode, int& qb, int& bh) {
    bh = i & 31;
    if (i < 192) { mode = 1; qb = 7 - (i >> 5); }
    else if (i < 384) { mode = 0; qb = 2 + ((i - 192) >> 5); }
    else if (i < 416) { mode = 1; qb = 1; } else if (i < 448) { mode = 0; qb = 1; } else if (i < 480) { mode = 1; qb = 0; } else { mode = 0; qb = 0; }
    return i < 512;
}
template <int SEL>
__device__ __forceinline__ void p4_loop(const Params& p, unsigned char* shm) {
    const int G = gridDim.x;
    for (int k = 0; k * G < 1024; ++k) {
        const int i = k * G + ((k & 1) ? G - 1 - (int)blockIdx.x : (int)blockIdx.x);
        if (i >= 1024) continue;
        if (SEL == 2) { if (i >= 512) gla_g3(p, i - 512, shm); continue; }
        int mode, qb, bh; if (!p4_decode(i, mode, qb, bh)) continue;
        if (mode != SEL) continue;
        attn_block<SEL>(p, bh >> 3, bh & 7, qb, shm);
    }
}
__device__ void phase_p4(const Params& p, unsigned char* shm) {
    p4_loop<1>(p, shm); p4_loop<0>(p, shm); p4_loop<2>(p, shm);
}
constexpr int NPHASE = 11;
#ifndef SUBSEL
#define SUBSEL 0
#endif
template <int PH>
__device__ __forceinline__ void run_phase(const Params& p, unsigned char* shm) {
    if constexpr (PH == 0) phase_convert(p, shm);
    if constexpr (PH == 1) run_gemm(shm, (const bf16_t*)(p.ws + WS_XB), (const bf16_t*)(p.ws + WS_WINT), NTOK, UW, DM, EpiU{(bf16_t*)(p.ws + WS_U)});
    if constexpr (PH == 2) phase_p2(p, shm);
    if constexpr (PH == 3) { for (int i = blockIdx.x; i < 256; i += gridDim.x) cmp_item(p, i, shm); phase_gla_scan(p); }
    if constexpr (PH == 4) phase_p4(p, shm);
    if constexpr (PH == 5) { phase_combine(p); transpose_w2(p, (float*)shm); }
    if constexpr (PH == 6) { run_gemm(shm, (const bf16_t*)(p.ws + WS_A), (const bf16_t*)(p.ws + WS_WOUTT), NTOK, DM, DM, EpiRes{p.x, p.out}); transpose_w13(p, (float*)shm); }
    if constexpr (PH == 7) phase_ln<true>(p, p.ln1_g, p.ln1_b);
    if constexpr (PH == 8) run_gemm(shm, (const bf16_t*)(p.ws + WS_HB), (const bf16_t*)(p.ws + WS_W13T), NTOK, 2 * FFH, DM, EpiGlu{(bf16_t*)(p.ws + WS_U)});
    if constexpr (PH == 9) run_gemm(shm, (const bf16_t*)(p.ws + WS_U), (const bf16_t*)(p.ws + WS_W2T), NTOK, DM, FFH, EpiRes{p.out, p.out});
    if constexpr (PH == 10) phase_ln<false>(p, p.ln2_g, p.ln2_b);
}
template <int PH, int HI, bool ONE>
__device__ __forceinline__ void run_range(const Params& p, unsigned char* shm, const XcdBarrier& xb) {
    if constexpr (PH < HI) {
        run_phase<PH>(p, shm);
#ifdef DUP_P2B
        if constexpr (ONE && PH == 2) { xcd_barrier(xb); phase_p2(p, shm, false); }
#endif
#ifdef DUP_PH2
        if constexpr (ONE && PH == DUP_PH2) { xcd_barrier(xb); run_phase<PH>(p, shm); }
#endif
#ifdef DUP_PH
        if constexpr (ONE && PH == DUP_PH) { xcd_barrier(xb); run_phase<PH>(p, shm); }
#endif
        if constexpr (ONE && PH + 1 < HI) { if constexpr (PH == 0) cg::this_grid().sync(); else xcd_barrier(xb); }
#ifdef EXTRA_SYNC
        if constexpr (ONE && PH == 0) { for (int i_ = 0; i_ < EXTRA_SYNC; ++i_) xcd_barrier(xb); }
#endif
        run_range<PH + 1, HI, ONE>(p, shm, xb);
    }
}
template <int LO, int HI, bool ONE>
__global__ __launch_bounds__(512, 2) void mk(Params p) {
    extern __shared__ __attribute__((aligned(16))) unsigned char shm[];
    XcdBarrier xb{};
    if constexpr (ONE) {
        volatile LAS unsigned* st = (volatile LAS unsigned*)(shm + LDS_BYTES - 16);
        if (threadIdx.x == 0) { st[0] = 0u; st[1] = 0u; }
        __syncthreads();
        xb = xcd_barrier_post((unsigned*)(p.ws + WS_BAR), st);
    }
    run_range<LO, HI, ONE>(p, shm, xb);
}
template <int PH> static void launch_one(int grid, const Params& p, hipStream_t stream) {
    static bool attr = false; if (!attr) { (void)hipFuncSetAttribute((const void*)mk<PH, PH + 1, false>, hipFuncAttributeMaxDynamicSharedMemorySize, LDS_BYTES); attr = true; }
    hipLaunchKernelGGL((mk<PH, PH + 1, false>), dim3(grid), dim3(512), LDS_BYTES, stream, p);
}

#ifndef MK_ONE
#define MK_ONE 0
#endif
extern "C" void kernel_launch(void* const* d_in, const int* in_sizes, int n_in, void* d_out, int out_size, void* d_ws, size_t ws_size, hipStream_t stream) {
    static int grid = 0;
    if (grid == 0) {
        if (n_in != 19 || out_size != NTOK * DM || ws_size < WS_END) { fprintf(stderr, "kernel_launch: unexpected shapes (n_in %d out %d ws %zu need %zu)\n", n_in, out_size, ws_size, (size_t)WS_END); grid = -1; return; }
        int dev = 0, cus = 0, per_cu = 0;
        (void)hipGetDevice(&dev); (void)hipDeviceGetAttribute(&cus, hipDeviceAttributeMultiprocessorCount, dev);
        #if MK_ONE
        (void)hipFuncSetAttribute((const void*)mk<0, NPHASE, true>, hipFuncAttributeMaxDynamicSharedMemorySize, LDS_BYTES);
        if (hipOccupancyMaxActiveBlocksPerMultiprocessor(&per_cu, (const void*)mk<0, NPHASE, true>, 512, LDS_BYTES) != hipSuccess || per_cu < 1) { fprintf(stderr, "kernel_launch: occupancy query says %d blocks per CU\n", per_cu); per_cu = 1; }
#endif
        (void)hipGetLastError();
        if (cus <= 0) cus = 256;
        grid = cus;
    }
    if (grid < 0) return;
    Params p{};
    p.x = (const float*)d_in[0]; p.w_in = (const float*)d_in[1]; p.gate_w2 = (const float*)d_in[2]; p.gate_b2 = (const float*)d_in[3]; p.norm_w = (const float*)d_in[4];
    p.ck_pos = (const float*)d_in[5]; p.ck_w1 = (const float*)d_in[6]; p.ck_w2 = (const float*)d_in[7]; p.cv_pos = (const float*)d_in[8]; p.cv_w1 = (const float*)d_in[9]; p.cv_w2 = (const float*)d_in[10];
    p.w_out = (const float*)d_in[11]; p.ln1_g = (const float*)d_in[12]; p.ln1_b = (const float*)d_in[13]; p.ffn_w1 = (const float*)d_in[14]; p.ffn_w3 = (const float*)d_in[15]; p.ffn_w2 = (const float*)d_in[16];
    p.ln2_g = (const float*)d_in[17]; p.ln2_b = (const float*)d_in[18];
    p.out = (float*)d_out; p.ws = (unsigned char*)d_ws;
#if MK_ONE
    (void)hipMemsetAsync((unsigned char*)d_ws + WS_BAR, 0, XCD_BAR_WORDS * 4, stream);
    void* args[] = {&p};
    hipError_t e = hipLaunchCooperativeKernel((const void*)mk<0, NPHASE, true>, dim3(grid), dim3(512), args, LDS_BYTES, stream);
    if (e != hipSuccess) fprintf(stderr, "cooperative launch failed: %s (grid %d)\n", hipGetErrorString(e), grid);
#else
    launch_one<0>(grid, p, stream); launch_one<1>(grid, p, stream); launch_one<2>(grid, p, stream); launch_one<3>(grid, p, stream); launch_one<4>(grid, p, stream); launch_one<5>(grid, p, stream);
    launch_one<6>(grid, p, stream); launch_one<7>(grid, p, stream); launch_one<8>(grid, p, stream); launch_one<9>(grid, p, stream); launch_one<10>(grid, p, stream);
#endif
}
```

```cpp
#include <hip/hip_runtime.h>
#include <hip/hip_cooperative_groups.h>
#include <cstdio>
#include <cstdint>
namespace cg = cooperative_groups;
#define MK_ONE 1
namespace pg8 {
#define PG8_LAS __attribute__((address_space(3)))
typedef unsigned short bf16_t;
typedef short bf16x8 __attribute__((ext_vector_type(8)));
typedef float f32x4 __attribute__((ext_vector_type(4)));
typedef unsigned u32x4 __attribute__((ext_vector_type(4)));
constexpr int BM = 256, BK = 64, HALF = 128, HTB = HALF * BK * 2  , STAGE_BYTES = 8 * HTB, NXCD = 8, WGM = 8;

__host__ __device__ __forceinline__ int lds_byte(int r, int c) { const int st = (r >> 4) * 2 + (c >> 5), rr = r & 15, cc = c & 31, ob = rr * 64 + cc * 2; return st * 1024 + (ob ^ (((ob >> 9) & 1) << 5)); }
__host__ __device__ __forceinline__ void stage_rc(int b, int& R, int& C) { const int st = b / 1024, sb = b % 1024, swz = sb ^ (((sb >> 9) & 1) << 5); R = (st >> 1) * 16 + swz / 64; C = (st & 1) * 32 + (swz % 64) / 2; }
__host__ __device__ __forceinline__ int perm32(int rho) { const int n = rho >> 4, i = rho & 15; return 8 * (i >> 2) + 4 * n + (i & 3); }

struct Unit { int pm, pn; };
struct Gemm { const bf16_t* A; const bf16_t* Bt; int M, N, K; };

struct StaticOrder {
    int nM, nN, nwg, G, c;
    __host__ __device__ void init(int M, int N, int G_, int c_) { nM = M / BM; nN = N / BM; nwg = nM * nN; G = G_; c = c_; }
    __host__ __device__ bool next(int i, Unit& u) const {
        const long L = (long)i * G + c; if (L >= nwg) return false;
        int wgid = (int)L; { const int q = nwg / NXCD, r = nwg % NXCD, xcd = wgid % NXCD, off = wgid / NXCD; wgid = (xcd < r ? xcd * (q + 1) : r * (q + 1) + (xcd - r) * q) + off; }
        const int nig = WGM * nN, gid = wgid / nig, fm = gid * WGM, gsz = (nM - fm) < WGM ? (nM - fm) : WGM;
        u.pm = fm + ((wgid % nig) % gsz); u.pn = (wgid % nig) / gsz; return true;
    }
    __device__ __forceinline__ void a_ready(const Unit&) const {}
    __device__ __forceinline__ void done(const Unit&) const {}
};
struct CountedOrder : StaticOrder {
    const unsigned* ready; unsigned need; unsigned* tmo;
    __device__ __forceinline__ void a_ready(const Unit& u) const {
        if (threadIdx.x < 64) {
            const unsigned long long t0 = __builtin_amdgcn_s_memrealtime(); unsigned polls = 0;
            while ((unsigned)__builtin_amdgcn_readfirstlane(__hip_atomic_load(ready + 64 * u.pm, __ATOMIC_RELAXED, __HIP_MEMORY_SCOPE_AGENT)) < need) {
                if ((++polls & 255u) == 0u && __builtin_amdgcn_readfirstlane(__hip_atomic_load(tmo, __ATOMIC_RELAXED, __HIP_MEMORY_SCOPE_AGENT)) != 0u) break;
                if (__builtin_amdgcn_s_memrealtime() - t0 > 2000000ull) {
                    if (threadIdx.x == 0) { unsigned expect = 0u; __hip_atomic_compare_exchange_strong(tmo + 1, &expect, 0x600u | (unsigned)(u.pm & 0xff), __ATOMIC_RELAXED, __ATOMIC_RELAXED, __HIP_MEMORY_SCOPE_AGENT); __hip_atomic_store(tmo, 1u, __ATOMIC_RELAXED, __HIP_MEMORY_SCOPE_AGENT); }
                    break; }
                __builtin_amdgcn_s_sleep(2); }
            __builtin_amdgcn_fence(__ATOMIC_ACQUIRE, "agent");
            asm volatile("s_waitcnt vmcnt(0)" ::: "memory");
        }
#if !defined(BROKEN_HOOK_NO_BARRIER)
        asm volatile("" ::: "memory"); __builtin_amdgcn_s_barrier(); asm volatile("" ::: "memory");
#endif
    }
};

__device__ __forceinline__ unsigned cvt_pk_bf16(float lo, float hi) { unsigned r; asm volatile("v_cvt_pk_bf16_f32 %0, %1, %2" : "=v"(r) : "v"(lo), "v"(hi)); return r; }
typedef float f32x2 __attribute__((ext_vector_type(2)));
__device__ __forceinline__ f32x2 gelu_pk(f32x2 v) {
    const f32x2 av = __builtin_elementwise_abs(v), d = av * 0.2316418882f + 1.0f;
    f32x2 t; t.x = __builtin_amdgcn_rcpf(d.x); t.y = __builtin_amdgcn_rcpf(d.y);
    f32x2 q = t * 0.5307027145f + (-0.7265760135f); q = q * t + 0.7107068705f; q = q * t + (-0.142248368f); q = q * t + 0.127414796f; q = q * t;
    const f32x2 s = (v * v) * (-0.72134752044f);
    f32x2 e; e.x = __builtin_amdgcn_exp2f(s.x); e.y = __builtin_amdgcn_exp2f(s.y);
    const f32x2 m = v * (q * e), r = v - m;
    f32x2 o; o.x = v.x < 0.f ? m.x : r.x; o.y = v.y < 0.f ? m.y : r.y; return o;
}

struct EpiF32 {
    static constexpr bool PERM = false, AFTER_DRAIN = false;
    float* C; int ldc; const float* bias;
    __device__ __forceinline__ void operator()(const f32x4 (&acc)[2][2][4][2], const Unit& u, int wr, int wc, int fr, int fq) const {
        const int row0 = u.pm * BM + wr * 64 + fr, col0 = u.pn * BM + wc * 32 + 4 * fq;
        f32x4 bv[2][2];
#pragma unroll
        for (int bj = 0; bj < 2; ++bj)
#pragma unroll
            for (int n = 0; n < 2; ++n) bv[bj][n] = bias ? *(const f32x4*)(bias + col0 + bj * HALF + n * 16) : (f32x4){0.f, 0.f, 0.f, 0.f};
#pragma unroll
        for (int ai = 0; ai < 2; ++ai)
#pragma unroll
            for (int m = 0; m < 4; ++m) { float* rowp = C + (size_t)(row0 + ai * HALF + m * 16) * ldc + col0;
#pragma unroll
                for (int bj = 0; bj < 2; ++bj)
#pragma unroll
                    for (int n = 0; n < 2; ++n) *(f32x4*)(rowp + bj * HALF + n * 16) = acc[ai][bj][m][n] + bv[bj][n]; }
    }
};
template <int ACT  > struct EpiBf16 {
    static constexpr bool PERM = true, AFTER_DRAIN = false;
    bf16_t* O; int ldc; const float* bias; int split_cols; size_t split_stride;
    __device__ __forceinline__ void operator()(const f32x4 (&acc)[2][2][4][2], const Unit& u, int wr, int wc, int fr, int fq) const {
        const int row0 = u.pm * BM + wr * 64 + fr; int colt = u.pn * BM; bf16_t* base = O;
        if (split_cols) { const int t = colt / split_cols; base += (size_t)t * split_stride; colt -= t * split_cols; }
        const int col0 = colt + wc * 32 + 8 * fq, bcol0 = u.pn * BM + wc * 32 + 8 * fq;
        f32x4 bv[2][2];
#pragma unroll
        for (int bj = 0; bj < 2; ++bj)
#pragma unroll
            for (int n = 0; n < 2; ++n) bv[bj][n] = bias ? *(const f32x4*)(bias + bcol0 + bj * HALF + 4 * n) : (f32x4){0.f, 0.f, 0.f, 0.f};
#pragma unroll
        for (int ai = 0; ai < 2; ++ai)
#pragma unroll
            for (int m = 0; m < 4; ++m) { bf16_t* rowp = base + (size_t)(row0 + ai * HALF + m * 16) * ldc + col0;
#pragma unroll
                for (int bj = 0; bj < 2; ++bj) { f32x4 v0 = acc[ai][bj][m][0] + bv[bj][0], v1 = acc[ai][bj][m][1] + bv[bj][1];
                    if (ACT == 1) { f32x2 a = gelu_pk((f32x2){v0[0], v0[1]}), b = gelu_pk((f32x2){v0[2], v0[3]}), c = gelu_pk((f32x2){v1[0], v1[1]}), d = gelu_pk((f32x2){v1[2], v1[3]});
                        v0 = (f32x4){a.x, a.y, b.x, b.y}; v1 = (f32x4){c.x, c.y, d.x, d.y}; }
                    if (ACT == 2) {
#pragma unroll
                        for (int j = 0; j < 4; ++j) { v0[j] = 0.5f * v0[j] * (1.0f + erff(v0[j] * 0.70710678f)); v1[j] = 0.5f * v1[j] * (1.0f + erff(v1[j] * 0.70710678f)); } }
                    u32x4 w; w.x = cvt_pk_bf16(v0[0], v0[1]); w.y = cvt_pk_bf16(v0[2], v0[3]); w.z = cvt_pk_bf16(v1[0], v1[1]); w.w = cvt_pk_bf16(v1[2], v1[3]);
                    *(u32x4*)(rowp + bj * HALF) = w; } }
    }
};

struct PanelStats {
    unsigned* xbuf;
    unsigned* cnt;
    unsigned* tmo;
    int ntn; float eps;
    unsigned code;
    __device__ __forceinline__ bool run(const f32x4 (&v)[2][2][4][2], const Unit& u, int wr, int wc, int fr, int fq, PG8_LAS unsigned char* lds, int wid, int lane) const {
        typedef float f32x2v __attribute__((ext_vector_type(2)));
        PG8_LAS f32x2v* P = (PG8_LAS f32x2v*)lds;
        PG8_LAS f32x2v* S = (PG8_LAS f32x2v*)(lds + 8192);
        PG8_LAS unsigned* flag = (PG8_LAS unsigned*)(lds + 8192 + 2048);
#pragma unroll
        for (int ai = 0; ai < 2; ++ai)
#pragma unroll
            for (int m = 0; m < 4; ++m) {
                float s = 0.f;
#pragma unroll
                for (int bj = 0; bj < 2; ++bj)
#pragma unroll
                    for (int n = 0; n < 2; ++n) { const f32x4 x = v[ai][bj][m][n]; s += (x[0] + x[1]) + (x[2] + x[3]); }
                s += __shfl_xor(s, 16); s += __shfl_xor(s, 32);
                const float mw = s * (1.0f / 64.0f); float q = 0.f;
#pragma unroll
                for (int bj = 0; bj < 2; ++bj)
#pragma unroll
                    for (int n = 0; n < 2; ++n) { const f32x4 d = v[ai][bj][m][n] - mw; q += (d[0] * d[0] + d[1] * d[1]) + (d[2] * d[2] + d[3] * d[3]); }
                q += __shfl_xor(q, 16); q += __shfl_xor(q, 32);
                if (fq == 0) P[(ai * HALF + wr * 64 + m * 16 + fr) * 4 + wc] = (f32x2v){mw, q};
            }
        asm volatile("s_waitcnt lgkmcnt(0)" ::: "memory"); __builtin_amdgcn_s_barrier(); asm volatile("" ::: "memory");
#if defined(BROKEN_NO_WAIT)
        if (blockIdx.x >= 64) { const long long t0 = clock64(); while (clock64() - t0 < 60000) __builtin_amdgcn_s_sleep(8); }
#endif
        const int row = wid * 32 + (lane & 31);
        if (lane < 32) {
            const f32x2v a = P[row * 4 + 0], b = P[row * 4 + 1], c = P[row * 4 + 2], d = P[row * 4 + 3];
            const float mt = (a.x + b.x + c.x + d.x) * 0.25f;
            const float da = a.x - mt, db = b.x - mt, dc = c.x - mt, dd = d.x - mt;
            const float m2 = (a.y + b.y) + (c.y + d.y) + 64.0f * ((da * da + db * db) + (dc * dc + dd * dd));
            unsigned long long* slot = (unsigned long long*)xbuf + ((size_t)(u.pm * BM + row) * 4 + u.pn);
            __hip_atomic_store(slot, ((unsigned long long)__float_as_uint(m2) << 32) | __float_as_uint(mt), __ATOMIC_RELAXED, __HIP_MEMORY_SCOPE_AGENT);
        }
        asm volatile("s_waitcnt vmcnt(0)" ::: "memory");
        if (lane == 0) __hip_atomic_fetch_add(cnt + 64 * u.pm, 1u, __ATOMIC_RELAXED, __HIP_MEMORY_SCOPE_AGENT);
        if (wid == 0) {
            bool dead = false; const unsigned long long t0 = __builtin_amdgcn_s_memrealtime(); const unsigned want = 8u * (unsigned)ntn;
            for (;;) {
#if defined(BROKEN_NO_WAIT)
                break;
#endif
                if ((unsigned)__builtin_amdgcn_readfirstlane(__hip_atomic_load(cnt + 64 * u.pm, __ATOMIC_RELAXED, __HIP_MEMORY_SCOPE_AGENT)) >= want) break;
                if (__builtin_amdgcn_s_memrealtime() - t0 > 2000000ull) {
                    if (lane == 0) { unsigned expect = 0u; __hip_atomic_compare_exchange_strong(tmo + 1, &expect, code | (unsigned)(u.pm & 0xff), __ATOMIC_RELAXED, __ATOMIC_RELAXED, __HIP_MEMORY_SCOPE_AGENT);
                                     __hip_atomic_store(tmo, 1u, __ATOMIC_RELAXED, __HIP_MEMORY_SCOPE_AGENT); }
                    dead = true; break; }
                __builtin_amdgcn_s_sleep(2);
            }
            __builtin_amdgcn_fence(__ATOMIC_ACQUIRE, "agent");
            if (lane == 0) flag[0] = dead ? 1u : 0u;
        }
        asm volatile("s_waitcnt vmcnt(0) lgkmcnt(0)" ::: "memory"); __builtin_amdgcn_s_barrier(); asm volatile("" ::: "memory");
        const bool bad = flag[0] != 0u;
        if (lane < 32) {
            const unsigned long long* slot = (const unsigned long long*)xbuf + (size_t)(u.pm * BM + row) * 4; float mt[4], m2[4]; float ms = 0.f;
#pragma unroll
            for (int t = 0; t < 4; ++t) { if (t < ntn) { const unsigned long long w = __hip_atomic_load(slot + t, __ATOMIC_RELAXED, __HIP_MEMORY_SCOPE_AGENT); mt[t] = __uint_as_float((unsigned)w); m2[t] = __uint_as_float((unsigned)(w >> 32)); } else { mt[t] = 0.f; m2[t] = 0.f; } ms += mt[t]; }
            const float mean = ms / (float)ntn; float q = 0.f;
#pragma unroll
            for (int t = 0; t < 4; ++t) if (t < ntn) { const float dm = mt[t] - mean; q += m2[t] + 256.0f * dm * dm; }
            S[row] = (f32x2v){mean, 1.0f / sqrtf(q / (256.0f * (float)ntn) + eps)};
        }
        asm volatile("s_waitcnt lgkmcnt(0)" ::: "memory"); __builtin_amdgcn_s_barrier(); asm volatile("" ::: "memory");
        return bad;
    }
};
struct EpiLnRes {
    static constexpr bool PERM = false, AFTER_DRAIN = true;
    const float* base; float* out; int ldc; const float* bias; PanelStats st; unsigned poison;
    __device__ __forceinline__ void refuse(size_t i0, size_t stride, int M, int N) const { const float q = __builtin_nanf(""); for (size_t i = i0; i < (size_t)M * N; i += stride) out[(i / N) * ldc + i % N] = q;
        if (i0 == 0) { unsigned expect = 0u; __hip_atomic_compare_exchange_strong(st.tmo + 1, &expect, 0x7f0u, __ATOMIC_RELAXED, __ATOMIC_RELAXED, __HIP_MEMORY_SCOPE_AGENT); __hip_atomic_store(st.tmo, 1u, __ATOMIC_RELAXED, __HIP_MEMORY_SCOPE_AGENT); } }
    __device__ __forceinline__ void fused(f32x4 (&acc)[2][2][4][2], const Unit& u, int wr, int wc, int fr, int fq, PG8_LAS unsigned char* lds, int wid, int lane) const {
        typedef float f32x2v __attribute__((ext_vector_type(2)));
        const PG8_LAS f32x2v* S = (const PG8_LAS f32x2v*)(lds + 8192);
        const int col0 = u.pn * BM + wc * 32 + 4 * fq;
#pragma unroll
        for (int bj = 0; bj < 2; ++bj)
#pragma unroll
            for (int n = 0; n < 2; ++n) { const f32x4 bv = bias ? *(const f32x4*)(bias + col0 + bj * HALF + n * 16) : (f32x4){0.f, 0.f, 0.f, 0.f};
#pragma unroll
                for (int ai = 0; ai < 2; ++ai)
#pragma unroll
                    for (int m = 0; m < 4; ++m) acc[ai][bj][m][n] += bv; }
        const bool bad = st.run(acc, u, wr, wc, fr, fq, lds, wid, lane) || poison != 0u;
        const float qnan = __builtin_nanf("");
#pragma unroll
        for (int ai = 0; ai < 2; ++ai)
#pragma unroll
            for (int m = 0; m < 4; ++m) { const int r = ai * HALF + wr * 64 + m * 16 + fr; const f32x2v sr = S[r]; const size_t off = (size_t)(u.pm * BM + r) * ldc + col0;
#pragma unroll
                for (int bj = 0; bj < 2; ++bj)
#pragma unroll
                    for (int n = 0; n < 2; ++n) { const f32x4 bs = *(const f32x4*)(base + off + bj * HALF + n * 16); f32x4 o = bs + (acc[ai][bj][m][n] - sr.x) * sr.y;
                        if (bad) o = (f32x4){qnan, qnan, qnan, qnan}; *(f32x4*)(out + off + bj * HALF + n * 16) = o; }
                asm volatile("" ::: "memory"); }
    }
};
struct EpiLnResLn {
    static constexpr bool PERM = false, AFTER_DRAIN = true;
    const float* base; float* out; bf16_t* xn; int ldc; const float* bias; PanelStats st1, st2; unsigned poison;
    __device__ __forceinline__ void refuse(size_t i0, size_t stride, int M, int N) const { const float q = __builtin_nanf(""); for (size_t i = i0; i < (size_t)M * N; i += stride) { const size_t o = (i / N) * ldc + i % N; out[o] = q; xn[o] = (bf16_t)0x7fc0u; }
        if (i0 == 0) { unsigned expect = 0u; __hip_atomic_compare_exchange_strong(st1.tmo + 1, &expect, 0x7f0u, __ATOMIC_RELAXED, __ATOMIC_RELAXED, __HIP_MEMORY_SCOPE_AGENT); __hip_atomic_store(st1.tmo, 1u, __ATOMIC_RELAXED, __HIP_MEMORY_SCOPE_AGENT); } }
    __device__ __forceinline__ void fused(f32x4 (&acc)[2][2][4][2], const Unit& u, int wr, int wc, int fr, int fq, PG8_LAS unsigned char* lds, int wid, int lane) const {
        typedef float f32x2v __attribute__((ext_vector_type(2))); typedef unsigned u32x2v __attribute__((ext_vector_type(2)));
        const PG8_LAS f32x2v* S = (const PG8_LAS f32x2v*)(lds + 8192);
        const int col0 = u.pn * BM + wc * 32 + 4 * fq;
#pragma unroll
        for (int bj = 0; bj < 2; ++bj)
#pragma unroll
            for (int n = 0; n < 2; ++n) { const f32x4 bv = bias ? *(const f32x4*)(bias + col0 + bj * HALF + n * 16) : (f32x4){0.f, 0.f, 0.f, 0.f};
#pragma unroll
                for (int ai = 0; ai < 2; ++ai)
#pragma unroll
                    for (int m = 0; m < 4; ++m) acc[ai][bj][m][n] += bv; }
        bool bad = st1.run(acc, u, wr, wc, fr, fq, lds, wid, lane) || poison != 0u;
        const float qnan = __builtin_nanf("");
#pragma unroll
        for (int ai = 0; ai < 2; ++ai)
#pragma unroll
            for (int m = 0; m < 4; ++m) { const int r = ai * HALF + wr * 64 + m * 16 + fr; const f32x2v sr = S[r]; const size_t off = (size_t)(u.pm * BM + r) * ldc + col0;
#pragma unroll
                for (int bj = 0; bj < 2; ++bj)
#pragma unroll
                    for (int n = 0; n < 2; ++n) { const f32x4 bs = *(const f32x4*)(base + off + bj * HALF + n * 16); acc[ai][bj][m][n] = bs + (acc[ai][bj][m][n] - sr.x) * sr.y; }
                asm volatile("" : "+v"(acc[ai][0][m][0]), "+v"(acc[ai][0][m][1]), "+v"(acc[ai][1][m][0]), "+v"(acc[ai][1][m][1]));
                if (m & 1) asm volatile("" ::: "memory"); }
        const bool bad1 = bad;
        bad = st2.run(acc, u, wr, wc, fr, fq, lds, wid, lane) || bad;
#pragma unroll
        for (int ai = 0; ai < 2; ++ai)
#pragma unroll
            for (int m = 0; m < 4; ++m) { const int r = ai * HALF + wr * 64 + m * 16 + fr; const f32x2v sr = S[r]; const size_t off = (size_t)(u.pm * BM + r) * ldc + col0;
#pragma unroll
                for (int bj = 0; bj < 2; ++bj)
#pragma unroll
                    for (int n = 0; n < 2; ++n) { const f32x4 x1 = acc[ai][bj][m][n]; *(f32x4*)(out + off + bj * HALF + n * 16) = bad1 ? (f32x4){qnan, qnan, qnan, qnan} : x1;
                        const f32x4 o = (x1 - sr.x) * sr.y; u32x2v w; w.x = cvt_pk_bf16(o[0], o[1]); w.y = cvt_pk_bf16(o[2], o[3]);
                        if (bad) { w.x = 0x7fc07fc0u; w.y = 0x7fc07fc0u; } *(u32x2v*)(xn + off + bj * HALF + n * 16) = w; }
                asm volatile("" ::: "memory"); }
    }
};

template <class Epi, class Sched, bool STAMP = false>
__device__ __forceinline__ void gemm_phase(PG8_LAS unsigned char* lds, const Gemm g, const Sched& S, const Epi& E, unsigned long long* stamps) {
    const int tid = threadIdx.x, wid = __builtin_amdgcn_readfirstlane(tid >> 6), lane = tid & 63, wr = wid >> 2, wc = wid & 3, fr = lane & 15, fq = lane >> 4;
    const int K = g.K, nt = K / BK;
    int ts_lo = 0, ts_hi = 0, nts = 0; const unsigned long long rt_entry = STAMP ? (unsigned long long)wall_clock64() : 0ull;
#define PG8_STAMP() do { if (STAMP && wid == 0 && nts < 64) { const unsigned long long _c = (unsigned long long)clock64(); \
        ts_lo = (lane == nts) ? (int)(unsigned)_c : ts_lo; ts_hi = (lane == nts) ? (int)(unsigned)(_c >> 32) : ts_hi; ++nts; } } while (0)
    PG8_STAMP();
    unsigned voffA[2], voffB[2];
#pragma unroll
    for (int i = 0; i < 2; ++i) { int R, C; stage_rc(tid * 16 + i * 8192, R, C); const int Rb = Epi::PERM ? ((R & ~31) + perm32(R & 31)) : R;
        voffA[i] = (unsigned)(R * K + C) * 2u; voffB[i] = (unsigned)(Rb * K + C) * 2u; }
    const size_t kstep = (size_t)(BK * 2);
    const size_t hstep = (size_t)HALF * K * 2;
    const size_t tstep = 2 * hstep;
    const unsigned ldsw = (unsigned)wid * 1024u;
    const int aoff = lds_byte(wr * 64 + fr, fq * 8), boff = lds_byte(wc * 32 + fr, fq * 8);
#define PG8_SA(b, h) (((b) * 2 + (h)) * HTB)
#define PG8_SB(b, h) ((4 + (b) * 2 + (h)) * HTB)
#define PG8_STAGE(bufoff, gbase, voff) do { _Pragma("unroll") for (int _i = 0; _i < 2; ++_i) \
        __builtin_amdgcn_global_load_lds((const unsigned*)((const char*)(gbase) + (voff)[_i]), (PG8_LAS unsigned*)(lds + (bufoff) + ldsw + _i * 8192), 16, 0, 0); } while (0)
#define PG8_LDA(dst, b, h) do { _Pragma("unroll") for (int m = 0; m < 4; ++m) _Pragma("unroll") for (int k = 0; k < 2; ++k) dst[m][k] = *(const PG8_LAS bf16x8*)(lds + PG8_SA(b, h) + aoff + m * 2048 + k * 1024); } while (0)
#define PG8_LDB(dst, b, h) do { _Pragma("unroll") for (int n = 0; n < 2; ++n) _Pragma("unroll") for (int k = 0; k < 2; ++k) dst[n][k] = *(const PG8_LAS bf16x8*)(lds + PG8_SB(b, h) + boff + n * 2048 + k * 1024); } while (0)
#define PG8_MMA(ai, bj, At, Bt) do { __builtin_amdgcn_s_setprio(1); _Pragma("unroll") for (int m = 0; m < 4; ++m) _Pragma("unroll") for (int n = 0; n < 2; ++n) _Pragma("unroll") for (int k = 0; k < 2; ++k) \
        acc[ai][bj][m][n] = __builtin_amdgcn_mfma_f32_16x16x32_bf16(Bt[n][k], At[m][k], acc[ai][bj][m][n], 0, 0, 0); __builtin_amdgcn_s_setprio(0); } while (0)
#define PG8_WAIT_V(n) asm volatile("s_waitcnt vmcnt(" #n ")" ::: "memory")
#define PG8_WAIT_L(n) asm volatile("s_waitcnt lgkmcnt(" #n ")" ::: "memory")
#define PG8_BAR __builtin_amdgcn_s_barrier()
#define PG8_SCHED __builtin_amdgcn_sched_barrier(0)
    Unit cur, nxt; int ui = 0;
    if (!S.next(0, cur)) return;
    f32x4 acc[2][2][4][2];
#pragma unroll
    for (int a = 0; a < 2; ++a)
#pragma unroll
        for (int b = 0; b < 2; ++b)
#pragma unroll
            for (int m = 0; m < 4; ++m)
#pragma unroll
                for (int n = 0; n < 2; ++n) acc[a][b][m][n] = (f32x4){0.f, 0.f, 0.f, 0.f};
    bf16x8 At[4][2], B0[2][2], B1[2][2];
    const char* cA = (const char*)g.A + (size_t)cur.pm * tstep; const char* cB = (const char*)g.Bt + (size_t)cur.pn * tstep;
    S.a_ready(cur);
    PG8_STAGE(PG8_SB(0, 0), cB, voffB); PG8_STAGE(PG8_SA(0, 0), cA, voffA); PG8_STAGE(PG8_SB(0, 1), cB + hstep, voffB); PG8_STAGE(PG8_SA(0, 1), cA + hstep, voffA);
    if (wr == 1) PG8_BAR;
    PG8_WAIT_V(4); PG8_BAR;
    PG8_STAGE(PG8_SB(1, 0), cB + kstep, voffB); PG8_STAGE(PG8_SA(1, 0), cA + kstep, voffA); PG8_STAGE(PG8_SB(1, 1), cB + hstep + kstep, voffB);
    PG8_WAIT_V(6); PG8_BAR;
    PG8_STAMP();
    for (;;) {
        const bool has_next = S.next(ui + 1, nxt);
        const char* nA = has_next ? (const char*)g.A + (size_t)nxt.pm * tstep : cA; const char* nB = has_next ? (const char*)g.Bt + (size_t)nxt.pn * tstep : cB;
        for (int t = 0; t < nt; t += 2) {
            const bool last = (t == nt - 2);
            const char* a1 = cA + (size_t)(t + 1) * kstep;
            const char* a2 = last ? nA : cA + (size_t)(t + 2) * kstep; const char* b2 = last ? nB : cB + (size_t)(t + 2) * kstep;
            const char* a3 = a2 + kstep; const char* b3 = b2 + kstep;
            if (last && has_next) S.a_ready(nxt);
            PG8_LDB(B0, 0, 0); PG8_SCHED; PG8_LDA(At, 0, 0); PG8_STAGE(PG8_SA(1, 1), a1 + hstep, voffA);
            PG8_WAIT_L(8); PG8_BAR; PG8_WAIT_L(0); PG8_MMA(0, 0, At, B0); PG8_BAR; PG8_SCHED;
            PG8_LDB(B1, 0, 1); PG8_STAGE(PG8_SB(0, 0), b2, voffB);
            PG8_BAR; PG8_WAIT_L(0); PG8_MMA(0, 1, At, B1); PG8_BAR;
            PG8_LDA(At, 0, 1); PG8_STAGE(PG8_SA(0, 0), a2, voffA);
            PG8_BAR; PG8_WAIT_L(0); PG8_MMA(1, 0, At, B0); PG8_BAR; PG8_SCHED;
            PG8_STAGE(PG8_SB(0, 1), b2 + hstep, voffB);
            PG8_WAIT_V(6); PG8_BAR; PG8_MMA(1, 1, At, B1); PG8_BAR;
            PG8_LDB(B0, 1, 0); PG8_SCHED; PG8_LDA(At, 1, 0); PG8_STAGE(PG8_SA(0, 1), a2 + hstep, voffA);
            PG8_WAIT_L(8); PG8_BAR; PG8_WAIT_L(0); PG8_MMA(0, 0, At, B0); PG8_BAR; PG8_SCHED;
            PG8_LDB(B1, 1, 1); PG8_STAGE(PG8_SB(1, 0), b3, voffB);
            PG8_BAR; PG8_WAIT_L(0); PG8_MMA(0, 1, At, B1); PG8_BAR;
            PG8_LDA(At, 1, 1); PG8_STAGE(PG8_SA(1, 0), a3, voffA);
            PG8_BAR; PG8_WAIT_L(0); PG8_MMA(1, 0, At, B0); PG8_BAR; PG8_SCHED;
            PG8_STAGE(PG8_SB(1, 1), b3 + hstep, voffB);
            PG8_WAIT_V(6); PG8_BAR; PG8_MMA(1, 1, At, B1); PG8_BAR;
        }
        PG8_STAMP();
        if constexpr (!Epi::AFTER_DRAIN) { E(acc, cur, wr, wc, fr, fq); S.done(cur); }
        PG8_STAMP();
        if (!has_next) break;
#pragma unroll
        for (int a = 0; a < 2; ++a)
#pragma unroll
            for (int b = 0; b < 2; ++b)
#pragma unroll
                for (int m = 0; m < 4; ++m)
#pragma unroll
                    for (int n = 0; n < 2; ++n) acc[a][b][m][n] = (f32x4){0.f, 0.f, 0.f, 0.f};
        cur = nxt; cA = nA; cB = nB; ++ui;
    }
    PG8_WAIT_V(0);
    if (wr == 0) PG8_BAR;
    PG8_BAR;
    if constexpr (Epi::AFTER_DRAIN) { E.fused(acc, cur, wr, wc, fr, fq, lds, wid, lane); S.done(cur); }
    PG8_STAMP();
    if (STAMP && wid == 0) { stamps[lane] = lane < nts ? (((unsigned long long)(unsigned)ts_hi << 32) | (unsigned)ts_lo) : 0ull;
        if (lane == 62) stamps[62] = rt_entry; if (lane == 63) stamps[63] = (unsigned long long)wall_clock64(); }
#undef PG8_STAMP
#undef PG8_SA
#undef PG8_SB
#undef PG8_STAGE
#undef PG8_LDA
#undef PG8_LDB
#undef PG8_MMA
#undef PG8_WAIT_V
#undef PG8_WAIT_L
#undef PG8_BAR
#undef PG8_SCHED
}
}

#define XB_TMO      128
#define XB_XCNT(j)  (256  + 64 * (j))
#define XB_XSUB(j)  (1280 + 64 * (j))
#define XB_XGEN(j)  (2304 + 64 * (j))
#define XB_TOP      3328
#define XB_TOPGEN   3392
#define XCD_BAR_WORDS 3456
#define XB_SPIN_CAP (1u << 18)
#define LAS __attribute__((address_space(3)))

__device__ __forceinline__ unsigned xb_ld(unsigned* p)              { return __hip_atomic_load(p, __ATOMIC_RELAXED, __HIP_MEMORY_SCOPE_AGENT); }
__device__ __forceinline__ unsigned xb_add(unsigned* p, unsigned v) { return __hip_atomic_fetch_add(p, v, __ATOMIC_RELAXED, __HIP_MEMORY_SCOPE_AGENT); }
__device__ __forceinline__ unsigned xb_xcc_id() { return (unsigned)__builtin_amdgcn_s_getreg((3 << 11) | 20) & 0xFu; }
#define XB_SPIN(cond, bar) do { unsigned _sp = 0; while (cond) { __builtin_amdgcn_s_sleep(1); \
    if ((++_sp & 255u) == 0u) { if (xb_ld(&(bar)[XB_TMO])) break; if (_sp > XB_SPIN_CAP) { atomicAdd(&(bar)[XB_TMO], 1u); break; } } } } while (0)

struct XcdBarrier {
    unsigned* bar; unsigned x;
    volatile LAS unsigned* st;
};

__device__ __forceinline__ XcdBarrier xcd_barrier_post(unsigned* bar, volatile LAS unsigned* st) {
    XcdBarrier b; b.bar = bar; b.x = xb_xcc_id(); b.st = st;
    if (threadIdx.x == 0) (void)xb_add(&bar[XB_XCNT(b.x)], 1u);
    return b;
}
__device__ __forceinline__ void xcd_barrier_complete(unsigned* bar, unsigned x, unsigned& nloc, unsigned& nx) {
    const unsigned G = gridDim.x * gridDim.y * gridDim.z;
    unsigned sum, cnt, mine, sp = 0u;
    for (;;) {
        sum = 0u; cnt = 0u; mine = 0u;
#pragma unroll
        for (unsigned j = 0; j < 16; ++j) { const unsigned c = xb_ld(&bar[XB_XCNT(j)]); sum += c; cnt += (c > 0u) ? 1u : 0u; mine = (j == x) ? c : mine; }
        if (sum == G) break;
        __builtin_amdgcn_s_sleep(1);
        if ((++sp & 255u) == 0u) { if (xb_ld(&bar[XB_TMO])) break; if (sp > XB_SPIN_CAP) { atomicAdd(&bar[XB_TMO], 1u); break; } }
    }
    nloc = mine > 0u ? mine : 1u; nx = cnt > 0u ? cnt : 1u;
}

__device__ __forceinline__ void xcd_barrier(const XcdBarrier& b) {
    asm volatile("s_waitcnt vmcnt(0)" ::: "memory");
    __syncthreads();
    if (threadIdx.x == 0) {
        unsigned* bar = b.bar;
        __builtin_amdgcn_s_waitcnt(0);
        unsigned nloc = b.st[0], nx = b.st[1];
        if (nloc == 0u) { xcd_barrier_complete(bar, b.x, nloc, nx); b.st[0] = nloc; b.st[1] = nx; }
        const unsigned old = xb_add(&bar[XB_XSUB(b.x)], 1u);
        const unsigned gen = old / nloc;
        if (old + 1u == (gen + 1u) * nloc) {
            __builtin_amdgcn_fence(__ATOMIC_RELEASE, "agent");
            asm volatile("s_waitcnt vmcnt(0)" ::: "memory");
            const unsigned og = xb_add(&bar[XB_TOP], 1u);
            const unsigned tg = og / nx;
            if (og + 1u == (tg + 1u) * nx) xb_add(&bar[XB_TOPGEN], 1u);
            else XB_SPIN(xb_ld(&bar[XB_TOPGEN]) == tg, bar);
            __builtin_amdgcn_fence(__ATOMIC_ACQUIRE, "agent");
            xb_add(&bar[XB_XGEN(b.x)], 1u);
            asm volatile("s_waitcnt vmcnt(0)" ::: "memory");
        } else {
            XB_SPIN(xb_ld(&bar[XB_XGEN(b.x)]) == gen, bar);
            __builtin_amdgcn_fence(__ATOMIC_ACQUIRE, "agent");
            asm volatile("s_waitcnt vmcnt(0)" ::: "memory");
        }
    }
    __syncthreads();
}


typedef unsigned short bf16_t;
typedef short bf16x8 __attribute__((ext_vector_type(8)));
typedef short s16x4 __attribute__((ext_vector_type(4)));
typedef float f32x4 __attribute__((ext_vector_type(4)));
typedef float f32x16 __attribute__((ext_vector_type(16)));
typedef unsigned u32x4 __attribute__((ext_vector_type(4)));
typedef unsigned u32x2 __attribute__((ext_vector_type(2)));

constexpr int NB = 4, SEQ = 2048, DM = 2048, NTOK = NB * SEQ;
constexpr int INW = 5672, UW = 5888, FFH = 5632;
constexpr float ALPHA = 1.189207115002721f;
constexpr float LN_EPS = 1e-5f;
constexpr int LDS_BYTES = 131072 + 8192;

constexpr size_t CH_BYTES = (size_t)NTOK * 128 * 2;
constexpr size_t WS_U = 0;
constexpr size_t WS_R1 = 45 * CH_BYTES;
constexpr size_t WS_XB = WS_R1;
constexpr size_t WS_WINT = WS_XB + (size_t)NTOK * DM * 2;
constexpr size_t WS_QR = WS_R1;
constexpr size_t WS_DS = WS_QR + 8 * CH_BYTES;
constexpr size_t WS_DECAY = WS_DS + (size_t)16 * 32 * 256 * 128 * 2;
constexpr size_t WS_KCMP = WS_DECAY + (size_t)16 * 32 * 128 * 4;
constexpr size_t WS_MASK = WS_KCMP + (size_t)2 * 4 * 2 * 128 * 128 * 2;
constexpr size_t WS_HB = WS_R1;
constexpr size_t WS_W2T = WS_HB + (size_t)NTOK * DM * 2;
constexpr size_t WS_R2 = WS_R1 + (size_t)NTOK * DM * 2 + (size_t)UW * DM * 2;
constexpr size_t WS_OP = WS_R2;
constexpr size_t WS_W13T = WS_R2;
constexpr size_t WS_A = WS_R2 + (size_t)3 * NTOK * 1024 * 2;
constexpr size_t WS_WOUTT = WS_A + (size_t)NTOK * DM * 2;
constexpr size_t WS_CW1T = WS_WOUTT + (size_t)DM * DM * 2;
constexpr size_t WS_CW2T = WS_CW1T + (size_t)2 * 256 * 4096 * 2;
constexpr size_t WS_C1P = WS_CW2T + (size_t)2 * 128 * 256 * 2;
constexpr size_t WS_ROPE = WS_C1P + (size_t)2 * 16 * 256 * 4;
constexpr size_t WS_BAR = WS_ROPE + (size_t)2 * 2048 * 16 * 4;
constexpr size_t WS_END = WS_BAR + 16384;

struct Params {
    const float* x; const float* w_in; const float* gate_w2; const float* gate_b2; const float* norm_w;
    const float* ck_pos; const float* ck_w1; const float* ck_w2; const float* cv_pos; const float* cv_w1; const float* cv_w2;
    const float* w_out; const float* ln1_g; const float* ln1_b; const float* ffn_w1; const float* ffn_w3; const float* ffn_w2;
    const float* ln2_g; const float* ln2_b;
    float* out; unsigned char* ws;
};

typedef __bf16 bf16x2_t __attribute__((ext_vector_type(2)));
typedef float f32x2_t __attribute__((ext_vector_type(2)));
__device__ __forceinline__ unsigned cvtpk(float lo, float hi) { f32x2_t v = {lo, hi}; bf16x2_t b = __builtin_convertvector(v, bf16x2_t); return __builtin_bit_cast(unsigned, b); }
__device__ __forceinline__ int otid() { int t = threadIdx.x; asm volatile("" : "+v"(t)); return t; }
__device__ __forceinline__ float bf2f(bf16_t b) { return __uint_as_float(((unsigned)b) << 16); }
__device__ __forceinline__ bf16_t f2bf(float f) { return (bf16_t)(cvtpk(f, 0.f) & 0xffffu); }
__device__ __forceinline__ float bflo(unsigned w) { return __uint_as_float(w << 16); }
__device__ __forceinline__ float bfhi(unsigned w) { return __uint_as_float(w & 0xffff0000u); }
__device__ __forceinline__ float sigmoidf_(float z) { return 1.0f / (1.0f + __expf(-z)); }
#define MFMA32(a, b, c) __builtin_amdgcn_mfma_f32_32x32x16_bf16((a), (b), (c), 0, 0, 0)
__device__ __forceinline__ int crow(int r, int hi) { return (r & 3) + 8 * (r >> 2) + 4 * hi; }
__device__ __forceinline__ bf16_t* uchunk(const Params& p, int c) { return (bf16_t*)(p.ws + WS_U + (size_t)c * CH_BYTES); }

struct EpiU {
    static constexpr bool PERM = true, AFTER_DRAIN = false;
    bf16_t* U;
    __device__ __forceinline__ void operator()(const pg8::f32x4 (&acc)[2][2][4][2], const pg8::Unit& u, int wr, int wc, int fr, int fq) const {
        const int row0 = u.pm * 256 + wr * 64 + fr;
#pragma unroll
        for (int bj = 0; bj < 2; ++bj) {
            const int ch = u.pn * 2 + bj; if (ch >= 45) continue;
            bf16_t* base = U + (size_t)ch * NTOK * 128 + wc * 32 + 8 * fq;
#pragma unroll
            for (int ai = 0; ai < 2; ++ai)
#pragma unroll
                for (int m = 0; m < 4; ++m) {
                    const pg8::f32x4 v0 = acc[ai][bj][m][0], v1 = acc[ai][bj][m][1];
                    u32x4 w; w.x = cvtpk(v0[0], v0[1]); w.y = cvtpk(v0[2], v0[3]); w.z = cvtpk(v1[0], v1[1]); w.w = cvtpk(v1[2], v1[3]);
                    *(u32x4*)(base + (size_t)(row0 + ai * 128 + m * 16) * 128) = w; }
        }
    }
};
struct EpiRes {
    static constexpr bool PERM = false, AFTER_DRAIN = false;
    const float* R; float* out;
    __device__ __forceinline__ void operator()(const pg8::f32x4 (&acc)[2][2][4][2], const pg8::Unit& u, int wr, int wc, int fr, int fq) const {
        const int row0 = u.pm * 256 + wr * 64 + fr, col0 = u.pn * 256 + wc * 32 + 4 * fq;
#pragma unroll
        for (int ai = 0; ai < 2; ++ai)
#pragma unroll
            for (int m = 0; m < 4; ++m) { const size_t off = (size_t)(row0 + ai * 128 + m * 16) * DM + col0;
#pragma unroll
                for (int bj = 0; bj < 2; ++bj)
#pragma unroll
                    for (int n = 0; n < 2; ++n) { const pg8::f32x4 r = *(const pg8::f32x4*)(R + off + bj * 128 + n * 16);
                        *(pg8::f32x4*)(out + off + bj * 128 + n * 16) = r * ALPHA + acc[ai][bj][m][n]; } }
    }
};
struct EpiGlu {
    static constexpr bool PERM = true, AFTER_DRAIN = false;
    bf16_t* T;
    __device__ __forceinline__ void operator()(const pg8::f32x4 (&acc)[2][2][4][2], const pg8::Unit& u, int wr, int wc, int fr, int fq) const {
        const int row0 = u.pm * 256 + wr * 64 + fr, col0 = u.pn * 128 + wc * 32 + 8 * fq;
#pragma unroll
        for (int ai = 0; ai < 2; ++ai)
#pragma unroll
            for (int m = 0; m < 4; ++m) {
                float t[8];
#pragma unroll
                for (int n = 0; n < 2; ++n)
#pragma unroll
                    for (int j = 0; j < 4; ++j) { const float a = acc[ai][0][m][n][j], b = acc[ai][1][m][n][j]; t[n * 4 + j] = a * b / (1.0f + __expf(-a)); }
                u32x4 w; w.x = cvtpk(t[0], t[1]); w.y = cvtpk(t[2], t[3]); w.z = cvtpk(t[4], t[5]); w.w = cvtpk(t[6], t[7]);
                *(u32x4*)(T + (size_t)(row0 + ai * 128 + m * 16) * FFH + col0) = w; }
    }
};

__device__ __forceinline__ void tr_tile(const float* src, int ld, int sc, bf16_t* dst, int dstK, int n0, int k0, float* tile) {
    const int tid = otid(), lane = tid & 63, w = __builtin_amdgcn_readfirstlane(tid >> 6);
#pragma unroll
    for (int i = 0; i < 8; ++i) { const int k = w * 8 + i; tile[k * 65 + lane] = sc >= 0 ? src[(size_t)(k0 + k) * ld + sc] : 0.f; }
    __syncthreads();
    const int n = tid >> 3, k8 = (tid & 7) * 8;
    float v[8];
#pragma unroll
    for (int i = 0; i < 8; ++i) v[i] = tile[(k8 + i) * 65 + n];
    u32x4 w4; w4.x = cvtpk(v[0], v[1]); w4.y = cvtpk(v[2], v[3]); w4.z = cvtpk(v[4], v[5]); w4.w = cvtpk(v[6], v[7]);
    *(u32x4*)(dst + (size_t)(n0 + n) * dstK + k0 + k8) = w4;
    __syncthreads();
}
__device__ __forceinline__ void tr_tile256(const float* src, int ld, int sc4, bf16_t* dst, int dstK, int n0, int k0, float* tile  ) {
    const int tid = otid(), lane = tid & 63, w = __builtin_amdgcn_readfirstlane(tid >> 6);
    f32x4 v[8];
#pragma unroll
    for (int i = 0; i < 8; ++i) { const int k = i * 8 + w; v[i] = sc4 >= 0 ? *(const f32x4*)(src + (size_t)(k0 + k) * ld + sc4) : (f32x4){0.f, 0.f, 0.f, 0.f}; }
#pragma unroll
    for (int i = 0; i < 8; ++i) { const int k = i * 8 + w; *(f32x4*)(tile + k * 260 + lane * 4) = v[i]; }
    __syncthreads();
    const int nl = (lane & 31) + 32 * w, kq = lane >> 5;
#pragma unroll
    for (int j = 0; j < 4; ++j) { const int k8 = (kq + 2 * j) * 8; float t[8];
#pragma unroll
        for (int i = 0; i < 8; ++i) t[i] = tile[(k8 + i) * 260 + nl];
        u32x4 w4; w4.x = cvtpk(t[0], t[1]); w4.y = cvtpk(t[2], t[3]); w4.z = cvtpk(t[4], t[5]); w4.w = cvtpk(t[6], t[7]);
        *(u32x4*)(dst + (size_t)(n0 + nl) * dstK + k0 + k8) = w4; }
    __syncthreads();
}
__device__ __forceinline__ int win_col(int n) {
    const int c = n >> 7, r = n & 127;
    if (c < 24) return n;
    if (c < 44) return 3088 + (c - 24) * 128 + r;
    if (c == 44) { if (r < 16) return 3072 + r; if (r < 40) return 5648 + (r - 16); }
    return -1;
}
__constant__ float ROPE_INV[16] = {1.000000000e+00f, 4.403665960e-01f, 1.939227432e-01f, 8.539710194e-02f, 3.760603070e-02f, 1.656043902e-02f, 7.292664610e-03f, 3.211445874e-03f,
                                   1.414213562e-03f, 6.227723788e-04f, 2.742481884e-04f, 1.207697351e-04f, 5.318296098e-05f, 2.341999971e-05f, 1.031338616e-05f, 4.541670478e-06f};

__device__ void transpose_w13(const Params& p, float* tile) {
    bf16_t* dst = (bf16_t*)(p.ws + WS_W13T);
    const int lane = otid() & 63;
    for (int it = blockIdx.x; it < 44 * 32; it += gridDim.x) { const int pn = it >> 5, kt = it & 31;
        const int which = lane >> 5, j0 = pn * 128 + (lane & 31) * 4;
        tr_tile256(which ? p.ffn_w3 : p.ffn_w1, FFH, j0, dst, DM, pn * 256, kt * 64, tile); }
}
__device__ void transpose_w2(const Params& p, float* tile) {
    bf16_t* dst = (bf16_t*)(p.ws + WS_W2T);
    const int lane = otid() & 63;
    for (int it = blockIdx.x; it < 8 * 88; it += gridDim.x) { const int nt = it / 88, kt = it % 88;
        tr_tile256(p.ffn_w2, DM, nt * 256 + lane * 4, dst, FFH, nt * 256, kt * 64, tile); }
}

__device__ void phase_convert(const Params& p, unsigned char* lds) {
    float* tile = (float*)lds;
    const int tid = otid(), lane = tid & 63;
    { const f32x4* xs = (const f32x4*)p.x; u32x2* xd = (u32x2*)(p.ws + WS_XB);
      for (size_t i = (size_t)blockIdx.x * 512 + tid; i < (size_t)NTOK * DM / 4; i += (size_t)gridDim.x * 512) { const f32x4 v = xs[i]; u32x2 w; w.x = cvtpk(v[0], v[1]); w.y = cvtpk(v[2], v[3]); xd[i] = w; } }
    { bf16_t* dst = (bf16_t*)(p.ws + WS_WINT);
      for (int it = blockIdx.x; it < 23 * 32; it += gridDim.x) { const int nt = it >> 5, kt = it & 31; tr_tile256(p.w_in, INW, win_col(nt * 256 + lane * 4), dst, DM, nt * 256, kt * 64, tile); } }
    { bf16_t* dst = (bf16_t*)(p.ws + WS_WOUTT);
      for (int it = blockIdx.x; it < 8 * 32; it += gridDim.x) { const int nt = it >> 5, kt = it & 31; tr_tile256(p.w_out, DM, nt * 256 + lane * 4, dst, DM, nt * 256, kt * 64, tile); } }
    for (int kv = 0; kv < 2; ++kv) {
        const float* w1 = kv ? p.cv_w1 : p.ck_w1; const float* w2 = kv ? p.cv_w2 : p.ck_w2;
        bf16_t* d1 = (bf16_t*)(p.ws + WS_CW1T) + (size_t)kv * 256 * 4096; bf16_t* d2 = (bf16_t*)(p.ws + WS_CW2T) + (size_t)kv * 128 * 256;
        for (int it = blockIdx.x; it < 64; it += gridDim.x) { tr_tile256(w1, 256, lane * 4, d1, 4096, 0, it * 64, tile); }
        for (int it = blockIdx.x; it < 2 * 4; it += gridDim.x) { const int nt = it >> 2, kt = it & 3; tr_tile(w2, 128, nt * 64 + lane, d2, 256, nt * 64, kt * 64, tile); }
    }
    for (int it = blockIdx.x; it < 32; it += gridDim.x) {
        const int kv = it >> 4, part = it & 15; const float* w1 = kv ? p.cv_w1 : p.ck_w1; const float* pos = kv ? p.cv_pos : p.ck_pos;
        const int j = tid & 255, half = tid >> 8; float s = 0.f;
        for (int i = 0; i < 128; ++i) { const int row = part * 256 + half * 128 + i; s += pos[row] * w1[(size_t)row * 256 + j]; }
        __syncthreads(); tile[tid] = s; __syncthreads();
        if (tid < 256) ((float*)(p.ws + WS_C1P))[(kv * 16 + part) * 256 + j] = tile[tid] + tile[tid + 256];
        __syncthreads();
    }
    { float* rc = (float*)(p.ws + WS_ROPE); float* rs = rc + 2048 * 16;
      for (int i = blockIdx.x * 512 + tid; i < 2048 * 16; i += gridDim.x * 512) { const int pos = i >> 4, k = i & 15;
          const float ang = (float)pos * ROPE_INV[k]; const double rev = (double)ang * 0.15915494309189535; const float fr = (float)(rev - rint(rev));
          rc[i] = __builtin_amdgcn_cosf(fr); rs[i] = __builtin_amdgcn_sinf(fr); } }
}

__device__ void phase_rope(const Params& p) {
    const float* rc = (const float*)(p.ws + WS_ROPE); const float* rs = rc + 2048 * 16;
    for (int idx = blockIdx.x * 512 + otid(); idx < 12 * NTOK; idx += gridDim.x * 512) {
        const int kind = idx / NTOK, tok = idx - kind * NTOK, pos = tok & (SEQ - 1);
        const bf16_t* src; bf16_t* dst;
        if (kind < 8) { src = uchunk(p, 24 + kind) + (size_t)tok * 128; dst = (bf16_t*)(p.ws + WS_QR) + ((size_t)kind * NTOK + tok) * 128; }
        else { const int c = kind < 10 ? 36 + (kind - 8) : 40 + (kind - 10); dst = uchunk(p, c) + (size_t)tok * 128; src = dst; }
        u32x4 a0 = ((const u32x4*)src)[0], a1 = ((const u32x4*)src)[1], b0 = ((const u32x4*)src)[2], b1 = ((const u32x4*)src)[3];
        unsigned xa[8] = {a0.x, a0.y, a0.z, a0.w, a1.x, a1.y, a1.z, a1.w}, xb[8] = {b0.x, b0.y, b0.z, b0.w, b1.x, b1.y, b1.z, b1.w};
        unsigned oa[8], ob[8];
#pragma unroll
        for (int i = 0; i < 8; ++i) {
            const float c0 = rc[pos * 16 + 2 * i], c1 = rc[pos * 16 + 2 * i + 1], s0 = rs[pos * 16 + 2 * i], s1 = rs[pos * 16 + 2 * i + 1];
            const float x10 = bflo(xa[i]), x11 = bfhi(xa[i]), x20 = bflo(xb[i]), x21 = bfhi(xb[i]);
            oa[i] = cvtpk(x10 * c0 - x20 * s0, x11 * c1 - x21 * s1);
            ob[i] = cvtpk(x20 * c0 + x10 * s0, x21 * c1 + x11 * s1);
        }
        ((u32x4*)dst)[0] = (u32x4){oa[0], oa[1], oa[2], oa[3]}; ((u32x4*)dst)[1] = (u32x4){oa[4], oa[5], oa[6], oa[7]};
        ((u32x4*)dst)[2] = (u32x4){ob[0], ob[1], ob[2], ob[3]}; ((u32x4*)dst)[3] = (u32x4){ob[4], ob[5], ob[6], ob[7]};
        if (kind < 8) {
#pragma unroll
            for (int i = 4; i < 16; ++i) ((u32x4*)dst)[i] = ((const u32x4*)src)[i];
        }
    }
}

struct GlaIn { float w2[16]; float bias; bf16_t g0, g1; };
__device__ __forceinline__ void gla_in_load(const Params& p, int h, size_t tok0, GlaIn& in) {
    const int tid = otid(), d = tid & 127;
    const bf16_t* u44 = uchunk(p, 44);
    in.g0 = u44[(tok0 + (tid >> 4)) * 128 + (tid & 15)]; in.g1 = u44[(tok0 + 32 + (tid >> 4)) * 128 + (tid & 15)];
#pragma unroll
    for (int r = 0; r < 16; ++r) in.w2[r] = p.gate_w2[r * 512 + h * 128 + d];
    in.bias = p.gate_b2[h * 128 + d];
}
__device__ __forceinline__ void gla_bc(const GlaIn& in, float* glr  , float* tot  , float (&bc)[16], float& blast) {
    const int tid = otid(), d = tid & 127, tq = tid >> 7;
    __syncthreads();
    glr[tid] = bf2f(in.g0); glr[512 + tid] = bf2f(in.g1);
    __syncthreads();
    float run = 0.f;
#pragma unroll
    for (int tt = 0; tt < 16; ++tt) { const int t = tq * 16 + tt; float z = in.bias;
#pragma unroll
        for (int r = 0; r < 16; ++r) z += glr[t * 16 + r] * in.w2[r];
        const float ls = fminf(z, 0.f) - log1pf(__expf(-fabsf(z)));
        run += ls * (1.0f / 16.0f); bc[tt] = run; }
    tot[tq * 128 + d] = run;
    __syncthreads();
    float off = 0.f, all = 0.f;
#pragma unroll
    for (int q = 0; q < 4; ++q) { const float v = tot[q * 128 + d]; all += v; if (q < tq) off += v; }
#pragma unroll
    for (int tt = 0; tt < 16; ++tt) bc[tt] += off;
    blast = all;
}
struct GlaV { u32x4 a[2], b[2]; };
__device__ __forceinline__ void gla_v_load(const Params& p, int h, size_t tok0, GlaV& v) {
    const int tid = otid();
#pragma unroll
    for (int i = 0; i < 2; ++i) { const int pc = tid + 512 * i, t2 = pc & 31, e8 = (pc >> 5) * 8;
        const bf16_t* src = uchunk(p, 8 + 2 * h + (e8 >> 7)) + (tok0 + 2 * t2) * 128 + (e8 & 127);
        v.a[i] = *(const u32x4*)src; v.b[i] = *(const u32x4*)(src + 128); }
}
__device__ __forceinline__ void gla_v_store(const GlaV& v, bf16_t* vT) {
    const int tid = otid(); unsigned* vw = (unsigned*)vT;
#pragma unroll
    for (int i = 0; i < 2; ++i) { const int pc = tid + 512 * i, t2 = pc & 31, e8 = (pc >> 5) * 8;
        const unsigned aw[4] = {v.a[i].x, v.a[i].y, v.a[i].z, v.a[i].w}, bw[4] = {v.b[i].x, v.b[i].y, v.b[i].z, v.b[i].w};
#pragma unroll
        for (int j = 0; j < 4; ++j) { vw[(e8 + 2 * j) * 36 + t2] = (aw[j] & 0xffffu) | (bw[j] << 16); vw[(e8 + 2 * j + 1) * 36 + t2] = (aw[j] >> 16) | (bw[j] & 0xffff0000u); } }
}
__device__ void gla_g1(const Params& p, int item, unsigned char* lds) {
    const int bh = item >> 5, n = item & 31, b = bh >> 2, h = bh & 3;
    const int tid = otid(), d = tid & 127, tq = tid >> 7, wid = __builtin_amdgcn_readfirstlane(tid >> 6), lane = tid & 63, r32 = lane & 31, hi = lane >> 5;
    float* glr = (float*)lds; float* tot = (float*)(lds + 4096);
    bf16_t* ksT = (bf16_t*)(lds + 8192); bf16_t* vT = (bf16_t*)(lds + 8192 + 128 * 72 * 2);
    const size_t tok0 = (size_t)b * SEQ + n * 64;
    GlaIn in; gla_in_load(p, h, tok0, in);
    const bf16_t* kc = uchunk(p, 4 + h); bf16_t kr[16];
#pragma unroll
    for (int tt = 0; tt < 16; ++tt) kr[tt] = kc[(tok0 + tq * 16 + tt) * 128 + d];
    GlaV vr; gla_v_load(p, h, tok0, vr);
    float bc[16], blast; gla_bc(in, glr, tot, bc, blast);
    { unsigned* kw = (unsigned*)ksT;
#pragma unroll
      for (int t2 = 0; t2 < 8; ++t2) kw[d * 36 + tq * 8 + t2] = cvtpk(bf2f(kr[2 * t2]) * __expf(blast - bc[2 * t2]), bf2f(kr[2 * t2 + 1]) * __expf(blast - bc[2 * t2 + 1])); }
    if (tq == 0) ((float*)(p.ws + WS_DECAY))[(size_t)item * 128 + d] = __expf(blast);
    gla_v_store(vr, vT);
    __syncthreads();
    f32x16 acc[4] = {};
#pragma unroll
    for (int ks = 0; ks < 4; ++ks) { const bf16x8 a = *(const bf16x8*)(vT + (wid * 32 + r32) * 72 + ks * 16 + hi * 8);
#pragma unroll
        for (int db = 0; db < 4; ++db) { const bf16x8 bb = *(const bf16x8*)(ksT + (db * 32 + r32) * 72 + ks * 16 + hi * 8); acc[db] = MFMA32(a, bb, acc[db]); } }
    bf16_t* ds = (bf16_t*)(p.ws + WS_DS) + (size_t)item * 256 * 128;
#pragma unroll
    for (int db = 0; db < 4; ++db)
#pragma unroll
        for (int r = 0; r < 16; ++r) ds[(wid * 32 + crow(r, hi)) * 128 + db * 32 + r32] = f2bf(acc[db][r]);
}
__device__ void phase_gla_scan(const Params& p) {
    bf16_t* ds = (bf16_t*)(p.ws + WS_DS); const float* dec = (const float*)(p.ws + WS_DECAY);
    for (int idx = blockIdx.x * 512 + otid(); idx < 16 * 256 * 16; idx += gridDim.x * 512) {
        const int bh = idx >> 12, e = (idx >> 4) & 255, d8 = (idx & 15) * 8;
        float st[8] = {0.f, 0.f, 0.f, 0.f, 0.f, 0.f, 0.f, 0.f};
#pragma unroll 4
        for (int n = 0; n < 32; ++n) {
            u32x4* ptr = (u32x4*)(ds + ((size_t)(bh * 32 + n) * 256 + e) * 128 + d8);
            const u32x4 w = *ptr; const f32x4 dc0 = *(const f32x4*)(dec + (size_t)(bh * 32 + n) * 128 + d8), dc1 = *(const f32x4*)(dec + (size_t)(bh * 32 + n) * 128 + d8 + 4);
            u32x4 o; o.x = cvtpk(st[0], st[1]); o.y = cvtpk(st[2], st[3]); o.z = cvtpk(st[4], st[5]); o.w = cvtpk(st[6], st[7]);
            *ptr = o;
            st[0] = dc0[0] * st[0] + bflo(w.x); st[1] = dc0[1] * st[1] + bfhi(w.x); st[2] = dc0[2] * st[2] + bflo(w.y); st[3] = dc0[3] * st[3] + bfhi(w.y);
            st[4] = dc1[0] * st[4] + bflo(w.z); st[5] = dc1[1] * st[5] + bfhi(w.z); st[6] = dc1[2] * st[6] + bflo(w.w); st[7] = dc1[3] * st[7] + bfhi(w.w);
        }
    }
}
__device__ void gla_g3(const Params& p, int item, unsigned char* lds) {
    const int bh = item >> 5, n = item & 31, b = bh >> 2, h = bh & 3;
    const int tid = otid(), d = tid & 127, tq = tid >> 7, wid = __builtin_amdgcn_readfirstlane(tid >> 6), lane = tid & 63, r32 = lane & 31, hi = lane >> 5;
    float* glr = (float*)lds; float* tot = (float*)(lds + 4096);
    bf16_t* qd = (bf16_t*)(lds + 8192); bf16_t* ki = (bf16_t*)(lds + 25600); bf16_t* vT = (bf16_t*)(lds + 43008); bf16_t* at = (bf16_t*)(lds + 79872);
    float* ol = (float*)(lds + 8192);
    const size_t tok0 = (size_t)b * SEQ + n * 64;
    GlaIn in; gla_in_load(p, h, tok0, in);
    const bf16_t* qc = uchunk(p, h); const bf16_t* kc = uchunk(p, 4 + h); bf16_t qr_[16], kr[16];
#pragma unroll
    for (int tt = 0; tt < 16; ++tt) { qr_[tt] = qc[(tok0 + tq * 16 + tt) * 128 + d]; kr[tt] = kc[(tok0 + tq * 16 + tt) * 128 + d]; }
    GlaV vr; gla_v_load(p, h, tok0, vr);
    float bc[16], blast; gla_bc(in, glr, tot, bc, blast);
#pragma unroll
    for (int tt = 0; tt < 16; ++tt) { const int t = tq * 16 + tt; const float e = __expf(bc[tt]);
        qd[t * 136 + d] = f2bf(bf2f(qr_[tt]) * 0.08838834764831845f * e);
        ki[t * 136 + d] = f2bf(bf2f(kr[tt]) / e); }
    gla_v_store(vr, vT);
    __syncthreads();
    const int ib = wid & 1, eb = (wid >> 1) * 2;
    f32x16 acc[2] = {};
    { const bf16_t* sp = (const bf16_t*)(p.ws + WS_DS) + (size_t)item * 256 * 128;
#pragma unroll
      for (int ks = 0; ks < 8; ++ks) { const bf16x8 a = *(const bf16x8*)(qd + (ib * 32 + r32) * 136 + ks * 16 + hi * 8);
#pragma unroll
          for (int x = 0; x < 2; ++x) { const bf16x8 bb = *(const bf16x8*)(sp + ((eb + x) * 32 + r32) * 128 + ks * 16 + hi * 8); acc[x] = MFMA32(a, bb, acc[x]); } } }
    if (wid < 4) { const int jb = wid >> 1; f32x16 s = {};
#pragma unroll
        for (int ks = 0; ks < 8; ++ks) { const bf16x8 a = *(const bf16x8*)(qd + (ib * 32 + r32) * 136 + ks * 16 + hi * 8); const bf16x8 bb = *(const bf16x8*)(ki + (jb * 32 + r32) * 136 + ks * 16 + hi * 8); s = MFMA32(a, bb, s); }
#pragma unroll
        for (int r = 0; r < 16; ++r) { const int i = ib * 32 + crow(r, hi), j = jb * 32 + r32; at[i * 72 + j] = f2bf(j <= i ? s[r] : 0.f); } }
    __syncthreads();
#pragma unroll
    for (int ks = 0; ks < 4; ++ks) { const bf16x8 a = *(const bf16x8*)(at + (ib * 32 + r32) * 72 + ks * 16 + hi * 8);
#pragma unroll
        for (int x = 0; x < 2; ++x) { const bf16x8 bb = *(const bf16x8*)(vT + ((eb + x) * 32 + r32) * 72 + ks * 16 + hi * 8); acc[x] = MFMA32(a, bb, acc[x]); } }
    __syncthreads();
#pragma unroll
    for (int x = 0; x < 2; ++x)
#pragma unroll
        for (int r = 0; r < 16; ++r) ol[(ib * 32 + crow(r, hi)) * 256 + (eb + x) * 32 + r32] = acc[x][r];
    __syncthreads();
    { const int row = tid >> 3, seg = tid & 7; const float* orow = ol + row * 256 + seg * 32; float ss = 0.f;
#pragma unroll
      for (int i = 0; i < 32; ++i) ss += orow[i] * orow[i];
      ss += __shfl_xor(ss, 1); ss += __shfl_xor(ss, 2); ss += __shfl_xor(ss, 4);
      const float rstd = rsqrtf(ss * (1.0f / 256.0f) + LN_EPS);
      const int e0 = seg * 32; const bf16_t* go = uchunk(p, 16 + 2 * h + (e0 >> 7)) + (tok0 + row) * 128 + (e0 & 127);
      bf16_t* dst = (bf16_t*)(p.ws + WS_A) + (tok0 + row) * DM + h * 256 + e0;
#pragma unroll
      for (int c = 0; c < 4; ++c) { const u32x4 g = ((const u32x4*)go)[c]; const unsigned gw[4] = {g.x, g.y, g.z, g.w}; unsigned ow[4];
#pragma unroll
          for (int i = 0; i < 4; ++i) { const int e = c * 8 + 2 * i; const float g0 = bflo(gw[i]), g1 = bfhi(gw[i]);
              const float v0 = orow[e] * rstd * p.norm_w[e0 + e] * g0 / (1.0f + __expf(-g0)), v1 = orow[e + 1] * rstd * p.norm_w[e0 + e + 1] * g1 / (1.0f + __expf(-g1));
              ow[i] = cvtpk(v0, v1); }
          ((u32x4*)dst)[c] = (u32x4){ow[0], ow[1], ow[2], ow[3]}; } }
    __syncthreads();
}

__device__ void compress_item(const Params& p, int item, unsigned char* lds) {
    const int kv = item >> 5, g = (item >> 4) & 1, rt = item & 15;
    const int tid = otid(), wid = __builtin_amdgcn_readfirstlane(tid >> 6), lane = tid & 63, r32 = lane & 31, hi = lane >> 5;
    const int srow = tid >> 3, sc = (tid & 7) * 8;
    const bf16_t* Ag = uchunk(p, 32 + 2 * kv + g) + (size_t)(rt * 32 + (srow & 31)) * 2048 + sc;
    const bf16_t* Wg = (const bf16_t*)(p.ws + WS_CW1T) + (size_t)kv * 256 * 4096 + (size_t)srow * 4096 + sc;
    bf16_t* Bs = (bf16_t*)lds;
    bf16_t* As = (bf16_t*)(lds + 2 * 256 * 72 * 2);
    bf16x8 rb[4], ra;
#pragma unroll
    for (int i = 0; i < 4; ++i) rb[i] = *(const bf16x8*)(Wg + (size_t)i * 64 * 4096);
    ra = *(const bf16x8*)Ag;
    f32x16 acc = {};
    __syncthreads();
    for (int kt = 0; kt < 64; ++kt) {
        bf16_t* bsb = Bs + (kt & 1) * 256 * 72; bf16_t* asb = As + (kt & 1) * 32 * 72;
#pragma unroll
        for (int i = 0; i < 4; ++i) *(bf16x8*)(bsb + (srow + 64 * i) * 72 + sc) = rb[i];
        if (tid < 256) *(bf16x8*)(asb + srow * 72 + sc) = ra;
        __syncthreads();
        if (kt + 1 < 64) {
#pragma unroll
            for (int i = 0; i < 4; ++i) rb[i] = *(const bf16x8*)(Wg + (size_t)i * 64 * 4096 + (kt + 1) * 64);
            ra = *(const bf16x8*)(Ag + (kt + 1) * 64);
        }
#pragma unroll
        for (int ks = 0; ks < 4; ++ks) { const bf16x8 a = *(const bf16x8*)(asb + r32 * 72 + ks * 16 + hi * 8); const bf16x8 bb = *(const bf16x8*)(bsb + (wid * 32 + r32) * 72 + ks * 16 + hi * 8); acc = MFMA32(a, bb, acc); }
    }
    __syncthreads();
    float* hid = (float*)lds;
    bf16_t* hb = (bf16_t*)(lds + 32768);
#pragma unroll
    for (int r = 0; r < 16; ++r) hid[crow(r, hi) * 256 + wid * 32 + r32] = acc[r];
    __syncthreads();
    float hv[16];
    { const float* c1p = (const float*)(p.ws + WS_C1P) + kv * 16 * 256;
#pragma unroll
      for (int ii = 0; ii < 16; ++ii) { const int i = ii * 512 + tid; const int j = i & 255; float v = hid[i];
#pragma unroll
          for (int q = 0; q < 16; ++q) v += c1p[q * 256 + j];
          const float u = 0.7978845608028654f * (v + 0.044715f * v * v * v); const float th = 1.0f - 2.0f / (__expf(2.0f * u) + 1.0f);
          hv[ii] = 0.5f * v * (1.0f + th); } }
    __syncthreads();
#pragma unroll
    for (int ii = 0; ii < 16; ++ii) { const int i = ii * 512 + tid; hb[(i >> 8) * 264 + (i & 255)] = f2bf(hv[ii]); }
    __syncthreads();
    if (wid < 4) { const bf16_t* W2 = (const bf16_t*)(p.ws + WS_CW2T) + (size_t)kv * 128 * 256 + (size_t)(wid * 32 + r32) * 256 + hi * 8; f32x16 o = {};
#pragma unroll
        for (int ks = 0; ks < 16; ++ks) { const bf16x8 a = *(const bf16x8*)(hb + r32 * 264 + ks * 16 + hi * 8); const bf16x8 bb = *(const bf16x8*)(W2 + ks * 16); o = MFMA32(a, bb, o); }
        bf16_t* dst = (bf16_t*)(p.ws + WS_KCMP) + (size_t)kv * 4 * 2 * 128 * 128;
#pragma unroll
        for (int r = 0; r < 16; ++r) { const int m = rt * 32 + crow(r, hi), bb_ = m >> 7, nn = m & 127; dst[((size_t)(bb_ * 2 + g) * 128 + nn) * 128 + wid * 32 + r32] = nn == 127 ? (bf16_t)0 : f2bf(o[r]); } }
    __syncthreads();
}

constexpr int SHM_K = 16384, SHM_V = 16384;
constexpr float SCALE = 0.08838834764831845f;
constexpr float THR = 8.f;
#define KSWZ(row, colB) ((row) * 256 + ((colB) ^ (((row) & 7) << 4)))
#define SBAR() __builtin_amdgcn_sched_barrier(0)
__device__ __forceinline__ int v_st(int k, int c) { const int kk = (k & ~0xC) | ((k & 4) << 1) | ((k & 8) >> 1); return ((kk >> 3) * 4 + (c >> 5)) * 512 + ((kk & 7) * 32 + (c & 31)) * 2; }
__device__ __forceinline__ int v_rd_base(int lane) { return ((lane & 3) << 3) | (((lane >> 2) & 3) << 6) | (((lane >> 4) & 1) << 5) | (((lane >> 5) & 1) << 8); }
constexpr int v_rd_off(int d0, int ks, int half) { return d0 * 512 + ks * 4096 + half * 2048; }
__device__ __forceinline__ void mask_tile(f32x16& p0, f32x16& p1, int dq, unsigned W) {
    const float NEG = -__builtin_inff();
#pragma unroll
    for (int r = 0; r < 16; ++r) { const int c = (r & 3) + 8 * (r >> 2);
        if ((unsigned)(dq - c) >= W) p0[r] = NEG;
        if ((unsigned)(dq - c - 32) >= W) p1[r] = NEG; }
}
__device__ __forceinline__ void partialSM(f32x16& p0, f32x16& p1, float& m_reg, float& mn, float& alpha) {
    float pmax = p0[0];
#pragma unroll
    for (int r = 1; r < 16; ++r) pmax = fmaxf(pmax, p0[r]);
#pragma unroll
    for (int r = 0; r < 16; ++r) pmax = fmaxf(pmax, p1[r]);
    { auto rr = __builtin_amdgcn_permlane32_swap(__float_as_uint(pmax), __float_as_uint(pmax), false, false);
      pmax = fmaxf(__uint_as_float(rr[0]), __uint_as_float(rr[1])); }
    constexpr float C2 = 1.4426950408889634f * SCALE;
    if (__builtin_expect(__all((pmax - m_reg) * SCALE <= THR), 1)) { mn = m_reg; alpha = 1.f; }
    else { mn = fmaxf(m_reg, pmax); alpha = __builtin_amdgcn_exp2f((m_reg - mn) * C2); m_reg = mn; }
    const float mnL = -mn * C2;
#pragma unroll
    for (int r = 0; r < 16; ++r) p0[r] = fmaf(p0[r], C2, mnL);
#pragma unroll
    for (int r = 0; r < 16; ++r) p1[r] = fmaf(p1[r], C2, mnL);
#pragma unroll
    for (int r = 0; r < 16; ++r) p0[r] = __builtin_amdgcn_exp2f(p0[r]);
}
#define PK4(P, B_, OUT) do { unsigned a0 = cvtpk(P[B_+0], P[B_+1]), a1 = cvtpk(P[B_+2], P[B_+3]);                          \
        unsigned b0 = cvtpk(P[B_+4], P[B_+5]), b1 = cvtpk(P[B_+6], P[B_+7]);                                             \
        auto r0 = __builtin_amdgcn_permlane32_swap(a0, b0, false, false); auto r1 = __builtin_amdgcn_permlane32_swap(a1, b1, false, false); \
        u32x4 w = {r0[0], r1[0], r0[1], r1[1]}; OUT = *reinterpret_cast<bf16x8*>(&w); } while (0)
__device__ __forceinline__ void pack_p(const f32x16& p0, const f32x16& p1, bf16x8& pa0, bf16x8& pa1, bf16x8& pa2, bf16x8& pa3) {
    PK4(p0, 0, pa0); PK4(p0, 8, pa1); PK4(p1, 0, pa2); PK4(p1, 8, pa3);
}
__device__ __forceinline__ void finishSM(f32x16& p0, f32x16& p1, float alpha, float& l_reg, bf16x8& pa0, bf16x8& pa1, bf16x8& pa2, bf16x8& pa3) {
#pragma unroll
    for (int r = 0; r < 16; ++r) p1[r] = __builtin_amdgcn_exp2f(p1[r]);
    float ps = 0;
#pragma unroll
    for (int r = 0; r < 16; ++r) ps += p0[r];
#pragma unroll
    for (int r = 0; r < 16; ++r) ps += p1[r];
    { auto rr = __builtin_amdgcn_permlane32_swap(__float_as_uint(ps), __float_as_uint(ps), false, false);
      ps = __uint_as_float(rr[0]) + __uint_as_float(rr[1]); }
    l_reg = l_reg * alpha + ps;
    pack_p(p0, p1, pa0, pa1, pa2, pa3);
}
template <int KB>
__device__ __forceinline__ void qkt(f32x16& p0, f32x16& p1, const char* K_lds, int r32, int hi, const bf16x8* qr) {
    p0 = f32x16{}; p1 = f32x16{};
    const char* kb[4];
#pragma unroll
    for (int dd = 0; dd < 4; ++dd) kb[dd] = K_lds + KB * SHM_K + KSWZ(r32, (dd * 16 + hi * 8) * 2);
#pragma unroll
    for (int d0 = 0; d0 < 8; ++d0) { const char* a = kb[d0 & 3] + (d0 >> 2) * 128;
        bf16x8 b0 = *reinterpret_cast<const bf16x8*>(a);
        bf16x8 b1 = *reinterpret_cast<const bf16x8*>(a + 32 * 256);
        p0 = MFMA32(b0, qr[d0], p0);
        p1 = MFMA32(b1, qr[d0], p1); }
}
template <int VB>
__device__ __forceinline__ void pv_tile(f32x16* o, int vb0, bf16x8 pa0, bf16x8 pa1, bf16x8 pa2, bf16x8 pa3) {
#define TRRD(dst, off) asm volatile("ds_read_b64_tr_b16 %0, %1 offset:%2" : "=&v"(dst) : "v"(vb0), "i"(off) : "memory")
#define PV_D0(d0) do { s16x4 l0, l1, l2, l3, h0, h1, h2, h3; constexpr int b_ = VB * SHM_V + v_rd_off(d0, 0, 0); \
        TRRD(l0, b_); TRRD(h0, b_ + 2048); TRRD(l1, b_ + 4096); TRRD(h1, b_ + 6144); TRRD(l2, b_ + 8192); TRRD(h2, b_ + 10240); TRRD(l3, b_ + 12288); TRRD(h3, b_ + 14336); \
        asm volatile("s_waitcnt lgkmcnt(0)" ::: "memory"); SBAR(); \
        o[d0] = MFMA32(pa0, ((bf16x8){l0[0], l0[1], l0[2], l0[3], h0[0], h0[1], h0[2], h0[3]}), o[d0]);   \
        o[d0] = MFMA32(pa1, ((bf16x8){l1[0], l1[1], l1[2], l1[3], h1[0], h1[1], h1[2], h1[3]}), o[d0]);   \
        o[d0] = MFMA32(pa2, ((bf16x8){l2[0], l2[1], l2[2], l2[3], h2[0], h2[1], h2[2], h2[3]}), o[d0]);   \
        o[d0] = MFMA32(pa3, ((bf16x8){l3[0], l3[1], l3[2], l3[3], h3[0], h3[1], h3[2], h3[3]}), o[d0]); } while (0)
    PV_D0(0); PV_D0(1); PV_D0(2); PV_D0(3);
#undef PV_D0
#undef TRRD
}
__device__ __forceinline__ void stage_kv(const bf16_t* Kg, const bf16_t* Vg, char* K_lds, char* V_lds, int bf) {
    const int tid = otid(), sr = tid >> 4, sc = (tid & 15) * 8;
    const bf16x8 k0 = *(const bf16x8*)(Kg + (size_t)sr * 128 + sc), k1 = *(const bf16x8*)(Kg + (size_t)(32 + sr) * 128 + sc);
    const bf16x8 v0 = *(const bf16x8*)(Vg + (size_t)sr * 128 + sc), v1 = *(const bf16x8*)(Vg + (size_t)(32 + sr) * 128 + sc);
    *(bf16x8*)(K_lds + bf * SHM_K + KSWZ(sr, sc * 2)) = k0; *(bf16x8*)(K_lds + bf * SHM_K + KSWZ(sr, sc * 2) + 32 * 256) = k1;
    *(bf16x8*)(V_lds + bf * SHM_V + v_st(sr, sc)) = v0; *(bf16x8*)(V_lds + bf * SHM_V + v_st(32 + sr, sc)) = v1;
}

struct KVRegs { bf16x8 k0, k1, v0, v1; };
__device__ __forceinline__ void kv_load(KVRegs& r, const bf16_t* Kg, const bf16_t* Vg, int sr, int sc) {
    r.k0 = *(const bf16x8*)(Kg + (size_t)sr * 128 + sc); r.k1 = *(const bf16x8*)(Kg + (size_t)(32 + sr) * 128 + sc);
    r.v0 = *(const bf16x8*)(Vg + (size_t)sr * 128 + sc); r.v1 = *(const bf16x8*)(Vg + (size_t)(32 + sr) * 128 + sc);
}
__device__ __forceinline__ void kv_store(const KVRegs& r, char* K_lds, char* V_lds, int sr, int sc) {
    *(bf16x8*)(K_lds + KSWZ(sr, sc * 2)) = r.k0; *(bf16x8*)(K_lds + KSWZ(sr, sc * 2) + 32 * 256) = r.k1;
    *(bf16x8*)(V_lds + v_st(sr, sc)) = r.v0; *(bf16x8*)(V_lds + v_st(32 + sr, sc)) = r.v1;
}
__device__ void cmp_item(const Params& p, int item, unsigned char* ldsu) {
    char* lds = (char*)ldsu;
    const int b = item >> 6, g = (item >> 5) & 1, tt = item & 31;
    const int tid = otid(), wid = __builtin_amdgcn_readfirstlane(tid >> 6), lane = tid & 63, r32 = lane & 31, hi = lane >> 5;
    const int hh = wid & 3, sb = wid >> 2, head = g * 4 + hh, t = tt * 64 + sb * 32 + r32;
    const size_t tok = (size_t)b * SEQ + t;
    char* V_lds = lds; char* K_lds = lds + 2 * SHM_V;
    float* wsf = (float*)(lds + 2 * SHM_V + 2 * SHM_K) + wid * 64;
    float* impw = (float*)(lds + 67584); float* imps = (float*)(lds + 67584 + 32768);
    const bf16_t* kc = (const bf16_t*)(p.ws + WS_KCMP) + (size_t)((0 * 4 + b) * 2 + g) * 128 * 128;
    const bf16_t* vc = (const bf16_t*)(p.ws + WS_KCMP) + (size_t)((1 * 4 + b) * 2 + g) * 128 * 128;
    __syncthreads();
    stage_kv(kc, vc, K_lds, V_lds, 0); stage_kv(kc + 64 * 128, vc + 64 * 128, K_lds, V_lds, 1);
    bf16x8 qr[8];
    { const bf16_t* Q = uchunk(p, 24 + head) + tok * 128;
#pragma unroll
      for (int d0 = 0; d0 < 8; ++d0) qr[d0] = *(const bf16x8*)(Q + d0 * 16 + hi * 8); }
    __syncthreads();
    const int nmax = (t - 31) >> 4; const float NEG = -__builtin_inff();
    constexpr float C2 = 1.4426950408889634f * SCALE;
    float* invw = (float*)(lds + 67584 + 32768 + 8192);
    float mx = NEG;
    { f32x16 s0, s1;
      qkt<0>(s0, s1, K_lds, r32, hi, qr);
#pragma unroll
      for (int r = 0; r < 16; ++r) { const int key = (r & 3) + 8 * (r >> 2) + 4 * hi; mx = fmaxf(mx, key <= nmax ? s0[r] : NEG); mx = fmaxf(mx, key + 32 <= nmax ? s1[r] : NEG); }
      SBAR(); qkt<1>(s0, s1, K_lds, r32, hi, qr);
#pragma unroll
      for (int r = 0; r < 16; ++r) { const int key = 64 + (r & 3) + 8 * (r >> 2) + 4 * hi; mx = fmaxf(mx, key <= nmax ? s0[r] : NEG); mx = fmaxf(mx, key + 32 <= nmax ? s1[r] : NEG); } }
    { auto rr = __builtin_amdgcn_permlane32_swap(__float_as_uint(mx), __float_as_uint(mx), false, false); mx = fmaxf(__uint_as_float(rr[0]), __uint_as_float(rr[1])); }
    const float mref = (mx == NEG) ? 0.f : mx, mnL = -mref * C2;
    float sum = 0.f, plPrev = 0.f;
    f32x16 o[4] = {};
    const int vb0 = (int)(uintptr_t)V_lds + v_rd_base(lane);
#define IMP_SRC(P, base) _Pragma("unroll") for (int q = 0; q < 4; ++q) { const float Gq = (P[4 * q] + P[4 * q + 1]) + (P[4 * q + 2] + P[4 * q + 3]); const float pl = __shfl_xor(P[4 * q + 3], 32); \
          impw[(wid * 32 + r32) * 32 + 2 * ((base) + q) + hi] = Gq + (hi ? pl : plPrev); plPrev = pl; }
#define CMP_TILE(TB) do { f32x16 p0, p1; bf16x8 pa0, pa1, pa2, pa3; qkt<TB>(p0, p1, K_lds, r32, hi, qr); \
      _Pragma("unroll") for (int r = 0; r < 16; ++r) { const int key = TB * 64 + (r & 3) + 8 * (r >> 2) + 4 * hi; \
          p0[r] = key <= nmax ? __builtin_amdgcn_exp2f(fmaf(p0[r], C2, mnL)) : 0.f; p1[r] = key + 32 <= nmax ? __builtin_amdgcn_exp2f(fmaf(p1[r], C2, mnL)) : 0.f; sum += p0[r] + p1[r]; } \
      SBAR(); IMP_SRC(p0, TB * 8) IMP_SRC(p1, TB * 8 + 4) SBAR(); \
      pack_p(p0, p1, pa0, pa1, pa2, pa3); pv_tile<TB>(o, vb0, pa0, pa1, pa2, pa3); } while (0)
    SBAR(); CMP_TILE(0); SBAR(); CMP_TILE(1); SBAR();
#undef CMP_TILE
#undef IMP_SRC
    { auto rr = __builtin_amdgcn_permlane32_swap(__float_as_uint(sum), __float_as_uint(sum), false, false); sum = __uint_as_float(rr[0]) + __uint_as_float(rr[1]); }
    const float inv = sum > 0.f ? 1.0f / sum : 0.f;
    if (hi == 0) { wsf[r32] = inv * sigmoidf_(bf2f(uchunk(p, 44)[tok * 128 + 16 + head * 3 + 0])); invw[wid * 32 + r32] = inv; }

    asm volatile("s_waitcnt lgkmcnt(0)" ::: "memory");
    { bf16_t* O = (bf16_t*)(p.ws + WS_OP) + ((size_t)b * SEQ + tt * 64 + sb * 32) * 1024 + head * 128;
#pragma unroll
      for (int r = 0; r < 16; ++r) { const int orow = crow(r, hi); const float gt = wsf[orow];
#pragma unroll
          for (int d0 = 0; d0 < 4; ++d0) O[(size_t)orow * 1024 + d0 * 32 + r32] = f2bf(o[d0][r] * gt); } }
    __syncthreads();
    { const int tokl = tid >> 3, jq = tid & 7, tpos = tt * 64 + tokl, cur = tpos >> 6, sbt = tokl >> 5, rr_ = tokl & 31;
#pragma unroll
      for (int jj = 0; jj < 4; ++jj) { const int j = jq * 4 + jj; float v = 0.f;
#pragma unroll
          for (int h4 = 0; h4 < 4; ++h4) v += impw[((sbt * 4 + h4) * 32 + rr_) * 32 + j] * invw[(sbt * 4 + h4) * 32 + rr_];
          if (j > cur) v = -1e4f;
          if (j == 0 || j == cur || j == cur - 1) v = 1e4f;
          imps[tokl * 32 + j] = v; }
      __syncthreads();
      float vi[32];
#pragma unroll
      for (int i = 0; i < 32; ++i) vi[i] = imps[tokl * 32 + i];
      unsigned word = 0;
#pragma unroll
      for (int jj = 0; jj < 4; ++jj) { const int j = jq * 4 + jj; const float vj = imps[tokl * 32 + j]; int cnt = 0;
#pragma unroll
          for (int i = 0; i < 32; ++i) cnt += (vi[i] > vj || (vi[i] == vj && i < j)) ? 1 : 0;
          if (cnt < 16) word |= 1u << j; }
      word |= __shfl_xor(word, 1); word |= __shfl_xor(word, 2); word |= __shfl_xor(word, 4);
      if (jq == 0) ((unsigned*)(p.ws + WS_MASK))[(size_t)(b * 2 + g) * SEQ + tpos] = word; }
    __syncthreads();
}

template <int MODE>
__device__ void attn_block(const Params& p, int b, int head, int qb, unsigned char* ldsu) {
    char* lds = (char*)ldsu;
    const int tid = otid(), wid = __builtin_amdgcn_readfirstlane(tid >> 6), lane = tid & 63, r32 = lane & 31, hi = lane >> 5;
    const int g = head >> 2, P0 = qb * 256, qlo = P0 + wid * 32, qpos = qlo + r32, qm = qpos - 4 * hi;
    const size_t tokb = (size_t)b * SEQ;
    char* V_lds = lds; char* K_lds = lds + 2 * SHM_V;
    float* wsf = (float*)(lds + 2 * SHM_V + 2 * SHM_K) + wid * 64; float* li_l = wsf; float* al_l = wsf + 32;
    const bf16_t* K = uchunk(p, (MODE ? 36 : 40) + g) + tokb * 128; const bf16_t* V = uchunk(p, (MODE ? 38 : 42) + g) + tokb * 128;
    bf16x8 qr[8];
    { const bf16_t* Q = (const bf16_t*)(p.ws + WS_QR) + ((size_t)head * NTOK + tokb + qpos) * 128;
#pragma unroll
      for (int d0 = 0; d0 < 8; ++d0) qr[d0] = *(const bf16x8*)(Q + d0 * 16 + hi * 8); }
    const unsigned msk = MODE ? ((const unsigned*)(p.ws + WS_MASK))[(size_t)(b * 2 + g) * SEQ + qpos] : 0u;
    const int j_lo = MODE ? 0 : ((P0 - 511 > 0 ? P0 - 511 : 0) >> 6), j_hi = qb * 4 + 4;
    float m_reg = -1e30f, l_reg = 0.f; f32x16 o[4] = {};
    const int vb0 = (int)(uintptr_t)V_lds + v_rd_base(lane);
    const int sr = tid >> 4, sc = (tid & 15) * 8;
    KVRegs kvr; kv_load(kvr, K + (size_t)j_lo * 64 * 128, V + (size_t)j_lo * 64 * 128, sr, sc);
    for (int j = j_lo; j < j_hi; ++j) {
        const int kb = j * 64;
        __syncthreads();
        kv_store(kvr, K_lds, V_lds, sr, sc);
        __syncthreads();
        if (j + 1 < j_hi) kv_load(kvr, K + (size_t)(kb + 64) * 128, V + (size_t)(kb + 64) * 128, sr, sc);
        const bool act = MODE ? (kb <= qlo + 31) : (kb <= qlo + 31 && kb + 63 >= qlo - 511);
        if (!act) continue;
        if (MODE) { if (!__any((int)((msk >> j) & 1u))) continue; }
        f32x16 p0, p1; float mn, alpha; bf16x8 pa0, pa1, pa2, pa3;
        qkt<0>(p0, p1, K_lds, r32, hi, qr);
        if (MODE == 0) { if (kb + 63 > qlo || kb <= qlo + 31 - 512) mask_tile(p0, p1, qm - kb, 512u); }
        else { if (kb + 63 > qlo) mask_tile(p0, p1, qm - kb, 0x7fffffffu);
               if (!((msk >> j) & 1u)) { const float NEG = -__builtin_inff();
#pragma unroll
                   for (int r = 0; r < 16; ++r) { p0[r] = NEG; p1[r] = NEG; } } }
        partialSM(p0, p1, m_reg, mn, alpha);
        if (__any(alpha < 1.f)) { if (hi == 0) al_l[r32] = alpha; asm volatile("s_waitcnt lgkmcnt(0)" ::: "memory");
#pragma unroll
            for (int d_ = 0; d_ < 4; ++d_)
#pragma unroll
                for (int r = 0; r < 16; ++r) o[d_][r] *= al_l[crow(r, hi)]; }
        finishSM(p0, p1, alpha, l_reg, pa0, pa1, pa2, pa3);
        pv_tile<0>(o, vb0, pa0, pa1, pa2, pa3);
    }
    if (hi == 0) { li_l[r32] = l_reg; al_l[r32] = sigmoidf_(bf2f(uchunk(p, 44)[(tokb + qpos) * 128 + 16 + head * 3 + (MODE ? 1 : 2)])); }
    asm volatile("s_waitcnt lgkmcnt(0)" ::: "memory");
    { bf16_t* O = (bf16_t*)(p.ws + WS_OP) + (size_t)(MODE ? 1 : 2) * NTOK * 1024 + (tokb + qlo) * 1024 + head * 128;
#pragma unroll
      for (int r = 0; r < 16; ++r) { const int orow = crow(r, hi); const float sc = al_l[orow] / li_l[orow];
#pragma unroll
          for (int d0 = 0; d0 < 4; ++d0) O[(size_t)orow * 1024 + d0 * 32 + r32] = f2bf(o[d0][r] * sc); } }
    __syncthreads();
}

__device__ void phase_combine(const Params& p) {
    const u32x4* o0 = (const u32x4*)(p.ws + WS_OP); const u32x4* o1 = o0 + (size_t)NTOK * 1024 / 8; const u32x4* o2 = o1 + (size_t)NTOK * 1024 / 8;
    bf16_t* A = (bf16_t*)(p.ws + WS_A);
    for (size_t i = (size_t)blockIdx.x * 512 + otid(); i < (size_t)NTOK * 128; i += (size_t)gridDim.x * 512) {
        const size_t tok = i >> 7; const int c8 = (int)(i & 127) * 8;
        const u32x4 a = o0[i], b = o1[i], c = o2[i]; u32x4 w;
        w.x = cvtpk(bflo(a.x) + bflo(b.x) + bflo(c.x), bfhi(a.x) + bfhi(b.x) + bfhi(c.x));
        w.y = cvtpk(bflo(a.y) + bflo(b.y) + bflo(c.y), bfhi(a.y) + bfhi(b.y) + bfhi(c.y));
        w.z = cvtpk(bflo(a.z) + bflo(b.z) + bflo(c.z), bfhi(a.z) + bfhi(b.z) + bfhi(c.z));
        w.w = cvtpk(bflo(a.w) + bflo(b.w) + bflo(c.w), bfhi(a.w) + bfhi(b.w) + bfhi(c.w));
        *(u32x4*)(A + tok * DM + 1024 + c8) = w;
    }
}

template <bool WRITE_BF>
__device__ void phase_ln(const Params& p, const float* gam, const float* bet) {
    const int wid = __builtin_amdgcn_readfirstlane(otid() >> 6), lane = otid() & 63;
    for (int row = blockIdx.x * 8 + wid; row < NTOK; row += gridDim.x * 8) {
        float* rp = p.out + (size_t)row * DM;
        f32x4 v[8]; float s = 0.f;
#pragma unroll
        for (int i = 0; i < 8; ++i) { v[i] = *(const f32x4*)(rp + (i * 64 + lane) * 4); s += (v[i][0] + v[i][1]) + (v[i][2] + v[i][3]); }
#pragma unroll
        for (int o = 32; o >= 1; o >>= 1) s += __shfl_xor(s, o);
        const float mean = s * (1.0f / DM); float q = 0.f;
#pragma unroll
        for (int i = 0; i < 8; ++i) { const f32x4 d = v[i] - mean; q += (d[0] * d[0] + d[1] * d[1]) + (d[2] * d[2] + d[3] * d[3]); }
#pragma unroll
        for (int o = 32; o >= 1; o >>= 1) q += __shfl_xor(q, o);
        const float rstd = rsqrtf(q * (1.0f / DM) + LN_EPS);
#pragma unroll
        for (int i = 0; i < 8; ++i) { const int c = (i * 64 + lane) * 4; const f32x4 gg = *(const f32x4*)(gam + c), bb = *(const f32x4*)(bet + c);
            const f32x4 y = (v[i] - mean) * rstd * gg + bb; *(f32x4*)(rp + c) = y;
            if (WRITE_BF) { u32x2 w; w.x = cvtpk(y[0], y[1]); w.y = cvtpk(y[2], y[3]); *(u32x2*)((bf16_t*)(p.ws + WS_HB) + (size_t)row * DM + c) = w; } }
    }
}

template <class Epi>
__device__ __forceinline__ void run_gemm(unsigned char* shm, const bf16_t* A, const bf16_t* Bt, int M, int N, int K, const Epi& E) {
    pg8::StaticOrder S; S.init(M, N, (int)gridDim.x, (int)blockIdx.x);
    pg8::Gemm g{A, Bt, M, N, K};
    pg8::gemm_phase<Epi, pg8::StaticOrder, false>((PG8_LAS unsigned char*)shm, g, S, E, nullptr);
    __syncthreads();
}
__device__ void phase_p2(const Params& p, unsigned char* shm, bool rope = true) {
    if (rope) phase_rope(p);
    const int G = gridDim.x, w = blockIdx.x;
    if (G > 64) { if (w < 64) compress_item(p, w, shm); else for (int i = w - 64; i < 512; i += G - 64) gla_g1(p, i, shm); }
    else { for (int i = w; i < 64; i += G) compress_item(p, i, shm); for (int i = w; i < 512; i += G) gla_g1(p, i, shm); }
}
__device__ __forceinline__ bool p4_decode(int i, int& mode, int& qb, int& bh) {
    bh = i & 31;
    if (i < 192) { mode = 1; qb = 7 - (i >> 5); }
    else if (i < 384) { mode = 0; qb = 2 + ((i - 192) >> 5); }
    else if (i < 416) { mode = 1; qb = 1; } else if (i < 448) { mode = 0; qb = 1; } else if (i < 480) { mode = 1; qb = 0; } else { mode = 0; qb = 0; }
    return i < 512;
}
template <int SEL>
__device__ __forceinline__ void p4_loop(const Params& p, unsigned char* shm) {
    const int G = gridDim.x;
    for (int k = 0; k * G < 1024; ++k) {
        const int i = k * G + ((k & 1) ? G - 1 - (int)blockIdx.x : (int)blockIdx.x);
        if (i >= 1024) continue;
        if (SEL == 2) { if (i >= 512) gla_g3(p, i - 512, shm); continue; }
        int mode, qb, bh; if (!p4_decode(i, mode, qb, bh)) continue;
        if (mode != SEL) continue;
        attn_block<SEL>(p, bh >> 3, bh & 7, qb, shm);
    }
}
__device__ void phase_p4(const Params& p, unsigned char* shm) {
    p4_loop<1>(p, shm); p4_loop<0>(p, shm); p4_loop<2>(p, shm);
}
constexpr int NPHASE = 11;
#ifndef SUBSEL
#define SUBSEL 0
#endif
template <int PH>
__device__ __forceinline__ void run_phase(const Params& p, unsigned char* shm) {
    if constexpr (PH == 0) phase_convert(p, shm);
    if constexpr (PH == 1) run_gemm(shm, (const bf16_t*)(p.ws + WS_XB), (const bf16_t*)(p.ws + WS_WINT), NTOK, UW, DM, EpiU{(bf16_t*)(p.ws + WS_U)});
    if constexpr (PH == 2) phase_p2(p, shm);
    if constexpr (PH == 3) { for (int i = blockIdx.x; i < 256; i += gridDim.x) cmp_item(p, i, shm); phase_gla_scan(p); }
    if constexpr (PH == 4) phase_p4(p, shm);
    if constexpr (PH == 5) { phase_combine(p); transpose_w2(p, (float*)shm); }
    if constexpr (PH == 6) { run_gemm(shm, (const bf16_t*)(p.ws + WS_A), (const bf16_t*)(p.ws + WS_WOUTT), NTOK, DM, DM, EpiRes{p.x, p.out}); transpose_w13(p, (float*)shm); }
    if constexpr (PH == 7) phase_ln<true>(p, p.ln1_g, p.ln1_b);
    if constexpr (PH == 8) run_gemm(shm, (const bf16_t*)(p.ws + WS_HB), (const bf16_t*)(p.ws + WS_W13T), NTOK, 2 * FFH, DM, EpiGlu{(bf16_t*)(p.ws + WS_U)});
    if constexpr (PH == 9) run_gemm(shm, (const bf16_t*)(p.ws + WS_U), (const bf16_t*)(p.ws + WS_W2T), NTOK, DM, FFH, EpiRes{p.out, p.out});
    if constexpr (PH == 10) phase_ln<false>(p, p.ln2_g, p.ln2_b);
}
template <int PH, int HI, bool ONE>
__device__ __forceinline__ void run_range(const Params& p, unsigned char* shm, const XcdBarrier& xb) {
    if constexpr (PH < HI) {
        run_phase<PH>(p, shm);
#ifdef DUP_CMPR
        if constexpr (ONE && PH == 2) { xcd_barrier(xb); if (blockIdx.x < 64) compress_item(p, blockIdx.x, shm); }
#endif
#ifdef DUP_P2B
        if constexpr (ONE && PH == 2) { xcd_barrier(xb); phase_p2(p, shm, false); }
#endif
#ifdef DUP_PH2
        if constexpr (ONE && PH == DUP_PH2) { xcd_barrier(xb); run_phase<PH>(p, shm); }
#endif
#ifdef DUP_PH
        if constexpr (ONE && PH == DUP_PH) { xcd_barrier(xb); run_phase<PH>(p, shm); }
#endif
        if constexpr (ONE && PH + 1 < HI) { if constexpr (PH == 0) cg::this_grid().sync(); else xcd_barrier(xb); }
#ifdef EXTRA_SYNC
        if constexpr (ONE && PH == 0) { for (int i_ = 0; i_ < EXTRA_SYNC; ++i_) xcd_barrier(xb); }
#endif
        run_range<PH + 1, HI, ONE>(p, shm, xb);
    }
}
template <int LO, int HI, bool ONE>
__global__ __launch_bounds__(512, 2) void mk(Params p) {
    extern __shared__ __attribute__((aligned(16))) unsigned char shm[];
    XcdBarrier xb{};
    if constexpr (ONE) {
        volatile LAS unsigned* st = (volatile LAS unsigned*)(shm + LDS_BYTES - 16);
        if (threadIdx.x == 0) { st[0] = 0u; st[1] = 0u; }
        __syncthreads();
        xb = xcd_barrier_post((unsigned*)(p.ws + WS_BAR), st);
    }
    run_range<LO, HI, ONE>(p, shm, xb);
}
template <int PH> static void launch_one(int grid, const Params& p, hipStream_t stream) {
    static bool attr = false; if (!attr) { (void)hipFuncSetAttribute((const void*)mk<PH, PH + 1, false>, hipFuncAttributeMaxDynamicSharedMemorySize, LDS_BYTES); attr = true; }
    hipLaunchKernelGGL((mk<PH, PH + 1, false>), dim3(grid), dim3(512), LDS_BYTES, stream, p);
}

#ifndef MK_ONE
#define MK_ONE 0
#endif
extern "C" void kernel_launch(void* const* d_in, const int* in_sizes, int n_in, void* d_out, int out_size, void* d_ws, size_t ws_size, hipStream_t stream) {
    static int grid = 0;
    if (grid == 0) {
        if (n_in != 19 || out_size != NTOK * DM || ws_size < WS_END) { fprintf(stderr, "kernel_launch: unexpected shapes (n_in %d out %d ws %zu need %zu)\n", n_in, out_size, ws_size, (size_t)WS_END); grid = -1; return; }
        int dev = 0, cus = 0, per_cu = 0;
        (void)hipGetDevice(&dev); (void)hipDeviceGetAttribute(&cus, hipDeviceAttributeMultiprocessorCount, dev);
        #if MK_ONE
        (void)hipFuncSetAttribute((const void*)mk<0, NPHASE, true>, hipFuncAttributeMaxDynamicSharedMemorySize, LDS_BYTES);
        if (hipOccupancyMaxActiveBlocksPerMultiprocessor(&per_cu, (const void*)mk<0, NPHASE, true>, 512, LDS_BYTES) != hipSuccess || per_cu < 1) { fprintf(stderr, "kernel_launch: occupancy query says %d blocks per CU\n", per_cu); per_cu = 1; }
#endif
        (void)hipGetLastError();
        if (cus <= 0) cus = 256;
        grid = cus;
    }
    if (grid < 0) return;
    Params p{};
    p.x = (const float*)d_in[0]; p.w_in = (const float*)d_in[1]; p.gate_w2 = (const float*)d_in[2]; p.gate_b2 = (const float*)d_in[3]; p.norm_w = (const float*)d_in[4];
    p.ck_pos = (const float*)d_in[5]; p.ck_w1 = (const float*)d_in[6]; p.ck_w2 = (const float*)d_in[7]; p.cv_pos = (const float*)d_in[8]; p.cv_w1 = (const float*)d_in[9]; p.cv_w2 = (const float*)d_in[10];
    p.w_out = (const float*)d_in[11]; p.ln1_g = (const float*)d_in[12]; p.ln1_b = (const float*)d_in[13]; p.ffn_w1 = (const float*)d_in[14]; p.ffn_w3 = (const float*)d_in[15]; p.ffn_w2 = (const float*)d_in[16];
    p.ln2_g = (const float*)d_in[17]; p.ln2_b = (const float*)d_in[18];
    p.out = (float*)d_out; p.ws = (unsigned char*)d_ws;
#if MK_ONE
    (void)hipMemsetAsync((unsigned char*)d_ws + WS_BAR, 0, XCD_BAR_WORDS * 4, stream);
    void* args[] = {&p};
    hipError_t e = hipLaunchCooperativeKernel((const void*)mk<0, NPHASE, true>, dim3(grid), dim3(512), args, LDS_BYTES, stream);
    if (e != hipSuccess) fprintf(stderr, "cooperative launch failed: %s (grid %d)\n", hipGetErrorString(e), grid);
#else
    launch_one<0>(grid, p, stream); launch_one<1>(grid, p, stream); launch_one<2>(grid, p, stream); launch_one<3>(grid, p, stream); launch_one<4>(grid, p, stream); launch_one<5>(grid, p, stream);
    launch_one<6>(grid, p, stream); launch_one<7>(grid, p, stream); launch_one<8>(grid, p, stream); launch_one<9>(grid, p, stream); launch_one<10>(grid, p, stream);
#endif
}
```
